# Optimizing an MI355X kernel written in HIP

```python
import jax, jax.numpy as jnp
from jax import lax
import numpy as np

D_MODEL = 4096
BATCH = 1
SEQ = 8192
DEPTH = 1

GRID_W = 64
CTX_LEN = 256
CHUNK = 128
HEAD_DIM = 128
MIX_WIDTH = D_MODEL
A_WIDTH = MIX_WIDTH // 2
A_GROUPS = A_WIDTH // HEAD_DIM
NA_WIDTH = MIX_WIDTH - A_WIDTH
NA_HEADS = NA_WIDTH // HEAD_DIM
NA_KH = 8
NA_KW = 16
IN_COLS = 2 * A_WIDTH + 3 * NA_WIDTH
KV_START = 2 * A_WIDTH + NA_WIDTH
D_FF = 256 * ((8 * D_MODEL // 3 + 255) // 256)
CONV_W = 3
EPS = 1e-6

kernel_name = "hybrid_gmlp_natten_dit_block"


def rmsnorm(x, g):
    x32 = x.astype(jnp.float32)
    y = x32 * lax.rsqrt(jnp.mean(x32 * x32, axis=-1, keepdims=True) + EPS)
    return (y * g.astype(jnp.float32)).astype(x.dtype)


def layernorm(x, g, b):
    x32 = x.astype(jnp.float32)
    mu = jnp.mean(x32, axis=-1, keepdims=True)
    var = jnp.mean(jnp.square(x32 - mu), axis=-1, keepdims=True)
    y = (x32 - mu) * lax.rsqrt(var + EPS)
    return (y * g.astype(jnp.float32) + b.astype(jnp.float32)).astype(x.dtype)


def adaln_params(cvec, w, b):
    m = jax.nn.silu(cvec) @ w + b
    return jnp.split(m[:, None, :], 6, axis=-1)


def modulate(h, shift, scale):
    return h * (1 + scale) + shift


def chunk_gmlp(u, v, ln_g, ln_b, w_s, b_s):
    B, N, _ = u.shape
    u = jax.nn.gelu(u)
    v = layernorm(jax.nn.gelu(v), ln_g, ln_b)
    v = v.reshape(B, N // CHUNK, CHUNK, A_GROUPS, HEAD_DIM)
    s = jnp.einsum('gpq,bnqgd->bnpgd', w_s, v) + b_s.T[None, None, :, :, None]
    return u * s.reshape(B, N, A_WIDTH)


def neighbourhood_attention(q, k, v, k_ctx, v_ctx, rpb):
    B, N, H, Dh = q.shape
    rows = N // GRID_W
    kh = min(NA_KH, rows)
    scale = Dh ** -0.5
    r = jnp.arange(rows)
    r0 = jnp.clip(r - kh // 2, 0, rows - kh)
    band = r0[:, None] + jnp.arange(kh)
    qg = q.reshape(B, rows, GRID_W, H, Dh)
    kg = k.reshape(B, rows, GRID_W, H, Dh)[:, band]
    vg = v.reshape(B, rows, GRID_W, H, Dh)[:, band]
    col = jnp.arange(GRID_W)
    c0 = jnp.clip(col - NA_KW // 2, 0, GRID_W - NA_KW)
    col_in = (col[None, :] >= c0[:, None]) & (col[None, :] < c0[:, None] + NA_KW)
    dr_idx = band - r[:, None] + (NA_KH - 1)
    dc_idx = jnp.clip(col[None, :] - col[:, None], -(NA_KW - 1), NA_KW - 1) + (NA_KW - 1)
    bias = rpb[:, dr_idx[:, None, :, None], dc_idx[None, :, None, :]]
    s_loc = jnp.einsum('brqhd,brikhd->bhrqik', qg, kg).astype(jnp.float32) * scale
    s_loc = s_loc + bias[None].astype(jnp.float32)
    s_loc = jnp.where(col_in[:, None, :], s_loc, -jnp.inf)
    s_ctx = jnp.einsum('brqhd,bchd->bhrqc', qg, k_ctx).astype(jnp.float32) * scale
    n_loc = kh * GRID_W
    s = jnp.concatenate([s_loc.reshape(B, H, rows, GRID_W, n_loc), s_ctx], axis=-1)
    p = jax.nn.softmax(s, axis=-1).astype(v.dtype)
    p_loc = p[..., :n_loc].reshape(B, H, rows, GRID_W, kh, GRID_W)
    p_ctx = p[..., n_loc:]
    out = jnp.einsum('bhrqik,brikhd->brqhd', p_loc, vg) + jnp.einsum('bhrqc,bchd->brqhd', p_ctx, v_ctx)
    return out.reshape(B, N, H * Dh)


def context_attention(q, k, v):
    s = jnp.einsum('bqhd,bkhd->bhqk', q, k).astype(jnp.float32) * (q.shape[-1] ** -0.5)
    p = jax.nn.softmax(s, axis=-1).astype(v.dtype)
    B, C = q.shape[0], q.shape[1]
    return jnp.einsum('bhqk,bkhd->bqhd', p, v).reshape(B, C, -1)


def conv_ffn(h, w_up, conv_w, conv_b, w_down):
    N = h.shape[1]
    a, g = jnp.split(h @ w_up, 2, axis=-1)
    pad = CONV_W // 2
    ap = jnp.pad(a, ((0, 0), (pad, pad), (0, 0)))
    a = conv_b + sum(ap[:, t:t + N] * conv_w[t] for t in range(CONV_W))
    return (jax.nn.silu(a) * g) @ w_down


def setup_inputs(seed: int = 0) -> dict:
    key = jax.random.key(seed)
    ks = jax.random.split(key, 22)
    f32 = jnp.float32

    def nrm(k, shape, s):
        return jax.random.normal(k, shape, f32) * s

    return {
        "x": nrm(ks[0], (BATCH, SEQ, D_MODEL), 1.0),
        "c": nrm(ks[1], (BATCH, D_MODEL), 1.0),
        "ctx": nrm(ks[2], (BATCH, CTX_LEN, D_MODEL), 1.0),
        "c_ctx": nrm(ks[3], (D_MODEL,), 1.0),
        "w_ada": nrm(ks[4], (DEPTH, D_MODEL, 6 * D_MODEL), D_MODEL ** -0.5),
        "b_ada": nrm(ks[5], (DEPTH, 6 * D_MODEL), 0.02),
        "g_norm1": 1.0 + nrm(ks[6], (DEPTH, D_MODEL), 0.02),
        "w_in": nrm(ks[7], (DEPTH, D_MODEL, IN_COLS), D_MODEL ** -0.5),
        "a_ln_g": 1.0 + nrm(ks[8], (DEPTH, A_WIDTH), 0.02),
        "a_ln_b": nrm(ks[9], (DEPTH, A_WIDTH), 0.02),
        "a_w_s": nrm(ks[10], (DEPTH, A_GROUPS, CHUNK, CHUNK), CHUNK ** -0.5),
        "a_b_s": 1.0 + nrm(ks[11], (DEPTH, A_GROUPS, CHUNK), 0.02),
        "na_rpb": nrm(ks[12], (DEPTH, NA_HEADS, 2 * NA_KH - 1, 2 * NA_KW - 1), 0.1),
        "w_out": nrm(ks[13], (DEPTH, MIX_WIDTH, D_MODEL), MIX_WIDTH ** -0.5),
        "g_norm2": 1.0 + nrm(ks[14], (DEPTH, D_MODEL), 0.02),
        "w_up": nrm(ks[15], (DEPTH, D_MODEL, 2 * D_FF), D_MODEL ** -0.5),
        "conv_w": nrm(ks[16], (DEPTH, CONV_W, D_FF), CONV_W ** -0.5),
        "conv_b": nrm(ks[17], (DEPTH, D_FF), 0.02),
        "w_down": nrm(ks[18], (DEPTH, D_FF, D_MODEL), D_FF ** -0.5),
        "g_final": 1.0 + nrm(ks[19], (D_MODEL,), 0.02),
    }


def reference(x, c, ctx, c_ctx, w_ada, b_ada, g_norm1, w_in, a_ln_g, a_ln_b, a_w_s, a_b_s,
              na_rpb, w_out, g_norm2, w_up, conv_w, conv_b, w_down, g_final):
    B, N, _ = x.shape
    for l in range(DEPTH):
        sh1, sc1, gt1, sh2, sc2, gt2 = adaln_params(c, w_ada[l], b_ada[l])
        csh1, csc1, cgt1, csh2, csc2, cgt2 = adaln_params(c_ctx[None], w_ada[l], b_ada[l])

        h = modulate(rmsnorm(x, g_norm1[l]), sh1, sc1)
        hc = modulate(rmsnorm(ctx, g_norm1[l]), csh1, csc1)
        u, v, q, k, va = jnp.split(h @ w_in[l], [A_WIDTH, 2 * A_WIDTH, 2 * A_WIDTH + NA_WIDTH,
                                                KV_START + NA_WIDTH], axis=-1)
        kc, vc = jnp.split(hc @ w_in[l][:, KV_START:], 2, axis=-1)
        C = ctx.shape[1]
        kc = kc.reshape(B, C, NA_HEADS, HEAD_DIM)
        vc = vc.reshape(B, C, NA_HEADS, HEAD_DIM)
        y_a = chunk_gmlp(u, v, a_ln_g[l], a_ln_b[l], a_w_s[l], a_b_s[l])
        y_b = neighbourhood_attention(q.reshape(B, N, NA_HEADS, HEAD_DIM),
                                      k.reshape(B, N, NA_HEADS, HEAD_DIM),
                                      va.reshape(B, N, NA_HEADS, HEAD_DIM), kc, vc, na_rpb[l])
        x_new = x + gt1 * (jnp.concatenate([y_a, y_b], axis=-1) @ w_out[l])

        h2 = modulate(rmsnorm(x_new, g_norm2[l]), sh2, sc2)
        x_new = x_new + gt2 * conv_ffn(h2, w_up[l], conv_w[l], conv_b[l], w_down[l])

        if l + 1 < DEPTH:
            uc, vgc, qc = jnp.split(hc @ w_in[l][:, :KV_START], [A_WIDTH, 2 * A_WIDTH], axis=-1)
            yc_a = chunk_gmlp(uc, vgc, a_ln_g[l], a_ln_b[l], a_w_s[l], a_b_s[l])
            yc_b = context_attention(qc.reshape(B, C, NA_HEADS, HEAD_DIM), kc, vc)
            ctx = ctx + cgt1 * (jnp.concatenate([yc_a, yc_b], axis=-1) @ w_out[l])
            hc2 = modulate(rmsnorm(ctx, g_norm2[l]), csh2, csc2)
            ctx = ctx + cgt2 * conv_ffn(hc2, w_up[l], conv_w[l], conv_b[l], w_down[l])
        x = x_new
    return rmsnorm(x, g_final)
```

```cpp
#include <hip/hip_runtime.h>
#include <cstdio>
#include <cstdint>

#ifndef MK_N_LAUNCHES
#define MK_N_LAUNCHES 1
#endif

namespace pg8 {
#define PG8_LAS __attribute__((address_space(3)))
typedef unsigned short bf16_t;
typedef short bf16x8 __attribute__((ext_vector_type(8)));
typedef float f32x4 __attribute__((ext_vector_type(4)));
typedef unsigned u32x4 __attribute__((ext_vector_type(4)));
constexpr int BM = 256, BK = 64, HALF = 128, HTB = HALF * BK * 2  , STAGE_BYTES = 8 * HTB, NXCD = 8, WGM = 8;

__host__ __device__ __forceinline__ int lds_byte(int r, int c) { const int st = (r >> 4) * 2 + (c >> 5), rr = r & 15, cc = c & 31, ob = rr * 64 + cc * 2; return st * 1024 + (ob ^ (((ob >> 9) & 1) << 5)); }
__host__ __device__ __forceinline__ void stage_rc(int b, int& R, int& C) { const int st = b / 1024, sb = b % 1024, swz = sb ^ (((sb >> 9) & 1) << 5); R = (st >> 1) * 16 + swz / 64; C = (st & 1) * 32 + (swz % 64) / 2; }
__host__ __device__ __forceinline__ int perm32(int rho) { const int n = rho >> 4, i = rho & 15; return 8 * (i >> 2) + 4 * n + (i & 3); }

struct Unit { int pm, pn; };
struct Gemm { const bf16_t* A; const bf16_t* Bt; int M, N, K; };

struct StaticOrder {
    int nM, nN, nwg, G, c;
    __host__ __device__ void init(int M, int N, int G_, int c_) { nM = M / BM; nN = N / BM; nwg = nM * nN; G = G_; c = c_; }
    __host__ __device__ bool next(int i, Unit& u) const {
        const long L = (long)i * G + c; if (L >= nwg) return false;
        int wgid = (int)L; { const int q = nwg / NXCD, r = nwg % NXCD, xcd = wgid % NXCD, off = wgid / NXCD; wgid = (xcd < r ? xcd * (q + 1) : r * (q + 1) + (xcd - r) * q) + off; }
        const int nig = WGM * nN, gid = wgid / nig, fm = gid * WGM, gsz = (nM - fm) < WGM ? (nM - fm) : WGM;
        u.pm = fm + ((wgid % nig) % gsz); u.pn = (wgid % nig) / gsz; return true;
    }
    __device__ __forceinline__ void a_ready(const Unit&) const {}
    __device__ __forceinline__ void done(const Unit&) const {}
};

typedef float f32x2_t __attribute__((ext_vector_type(2))); typedef __bf16 bf16x2_t __attribute__((ext_vector_type(2)));
__device__ __forceinline__ unsigned cvtpk(float lo, float hi) { f32x2_t v = {lo, hi}; bf16x2_t b = __builtin_convertvector(v, bf16x2_t); return __builtin_bit_cast(unsigned, b); }
__device__ __forceinline__ float gelu_t(float x) { const float u = x * (1.0f + 0.044715f * x * x); const float e = __builtin_amdgcn_exp2f(-2.302208198f * u); return x * __builtin_amdgcn_rcpf(1.0f + e); }
__device__ __forceinline__ float silu_f(float x) { const float e = __builtin_amdgcn_exp2f(-1.4426950409f * x); return x * __builtin_amdgcn_rcpf(1.0f + e); }

struct EpiIn {
    static constexpr bool PERM = true, AFTER_DRAIN = false;
    bf16_t* base; size_t seg_stride; float* vst;
    __device__ __forceinline__ void operator()(const f32x4 (&acc)[2][2][4][2], const Unit& u, int wr, int wc, int fr, int fq) const {
        const int seg = u.pn >> 3, colt = (u.pn & 7) * BM;
        bf16_t* O = base + (size_t)seg * seg_stride;
        const int row0 = u.pm * BM + wr * 64 + fr, col0 = colt + wc * 32 + 8 * fq;
#pragma unroll
        for (int ai = 0; ai < 2; ++ai)
#pragma unroll
            for (int m = 0; m < 4; ++m) { const int row = row0 + ai * HALF + m * 16; bf16_t* rowp = O + (size_t)row * 2048 + col0; float s = 0.f, s2 = 0.f;
#pragma unroll
                for (int bj = 0; bj < 2; ++bj) { f32x4 v0 = acc[ai][bj][m][0], v1 = acc[ai][bj][m][1];
                    if (seg < 2) {
#pragma unroll
                        for (int j = 0; j < 4; ++j) { v0[j] = gelu_t(v0[j]); v1[j] = gelu_t(v1[j]); }
                    }
                    if (seg == 1) {
#pragma unroll
                        for (int j = 0; j < 4; ++j) { s += v0[j] + v1[j]; s2 += v0[j] * v0[j] + v1[j] * v1[j]; }
                    }
                    u32x4 w; w.x = cvtpk(v0[0], v0[1]); w.y = cvtpk(v0[2], v0[3]); w.z = cvtpk(v1[0], v1[1]); w.w = cvtpk(v1[2], v1[3]);
                    *(u32x4*)(rowp + bj * HALF) = w; }
                if (seg == 1) { s += __shfl_xor(s, 16); s += __shfl_xor(s, 32); s2 += __shfl_xor(s2, 16); s2 += __shfl_xor(s2, 32);
                    if (fq == 0) { f32x2_t pr = {s, s2}; *(f32x2_t*)(vst + ((size_t)row * 32 + (u.pn - 8) * 4 + wc) * 2) = pr; } }
            }
    }
};
struct EpiRes {
    static constexpr bool PERM = false, AFTER_DRAIN = false;
    const float* base; float* out; const float* gate;
    __device__ __forceinline__ void operator()(const f32x4 (&acc)[2][2][4][2], const Unit& u, int wr, int wc, int fr, int fq) const {
        const int row0 = u.pm * BM + wr * 64 + fr, col0 = u.pn * BM + wc * 32 + 4 * fq;
        f32x4 gv[2][2];
#pragma unroll
        for (int bj = 0; bj < 2; ++bj)
#pragma unroll
            for (int n = 0; n < 2; ++n) gv[bj][n] = *(const f32x4*)(gate + col0 + bj * HALF + n * 16);
#pragma unroll
        for (int ai = 0; ai < 2; ++ai) {
            f32x4 bs[4][2][2];
#pragma unroll
            for (int m = 0; m < 4; ++m) { const size_t off = (size_t)(row0 + ai * HALF + m * 16) * 4096 + col0;
#pragma unroll
                for (int bj = 0; bj < 2; ++bj)
#pragma unroll
                    for (int n = 0; n < 2; ++n) bs[m][bj][n] = *(const f32x4*)(base + off + bj * HALF + n * 16); }
#pragma unroll
            for (int m = 0; m < 4; ++m) { const size_t off = (size_t)(row0 + ai * HALF + m * 16) * 4096 + col0;
#pragma unroll
                for (int bj = 0; bj < 2; ++bj)
#pragma unroll
                    for (int n = 0; n < 2; ++n) *(f32x4*)(out + off + bj * HALF + n * 16) = bs[m][bj][n] + gv[bj][n] * acc[ai][bj][m][n]; }
            asm volatile("" ::: "memory"); }
    }
};
template <int CTRL> __device__ __forceinline__ float dppf(float x) { return __builtin_bit_cast(float, __builtin_amdgcn_update_dpp(0, __builtin_bit_cast(int, x), CTRL, 0xf, 0xf, false)); }
struct EpiUpConv {
    static constexpr bool PERM = true, AFTER_DRAIN = false;
    bf16_t* ACT; float* HALO; const float* cw; const float* cb; int ld; int nrows;
    __device__ __forceinline__ void operator()(const f32x4 (&acc)[2][2][4][2], const Unit& u, int wr, int wc, int fr, int fq) const {
        const int ch0 = u.pn * HALF + wc * 32 + 8 * fq;
        float w0[8], w1[8], w2[8], bb[8];
#pragma unroll
        for (int h4 = 0; h4 < 2; ++h4) { const f32x4 a = *(const f32x4*)(cw + ch0 + 4 * h4), b = *(const f32x4*)(cw + ld + ch0 + 4 * h4), c = *(const f32x4*)(cw + 2 * ld + ch0 + 4 * h4), d = *(const f32x4*)(cb + ch0 + 4 * h4);
#pragma unroll
            for (int j = 0; j < 4; ++j) { w0[4 * h4 + j] = a[j]; w1[4 * h4 + j] = b[j]; w2[4 * h4 + j] = c[j]; bb[4 * h4 + j] = d[j]; } }
#pragma unroll
        for (int ai = 0; ai < 2; ++ai) { const int Rb = u.pm * BM + ai * HALF + wr * 64;
#pragma unroll
            for (int m = 0; m < 4; ++m) { float t[8], y[8];
#pragma unroll
                for (int c = 0; c < 8; ++c) { const int n = c >> 2, j = c & 3;
                    const float a = acc[ai][0][m][n][j];
                    const float am = m > 0 ? acc[ai][0][m > 0 ? m - 1 : 0][n][j] : 0.f, ap = m < 3 ? acc[ai][0][m < 3 ? m + 1 : 3][n][j] : 0.f;
                    const float prev = dppf<0x121>(fr == 15 ? am : a);
                    const float next = dppf<0x12F>(fr == 0 ? ap : a);
                    t[c] = bb[c] + w0[c] * prev + w1[c] * a + w2[c] * next;
                    y[c] = silu_f(t[c]) * acc[ai][1][m][n][j]; }
                const int row = Rb + 16 * m + fr;
                u32x4 w; w.x = cvtpk(y[0], y[1]); w.y = cvtpk(y[2], y[3]); w.z = cvtpk(y[4], y[5]); w.w = cvtpk(y[6], y[7]);
                *(u32x4*)(ACT + (size_t)row * ld + ch0) = w;
                if (m == 0 || m == 3) { const bool up = (m == 3);
                    const int R = up ? Rb + 64 : Rb;
                    if (fr == (up ? 15 : 0) && R != 0 && R != nrows) { float* hp = HALO + ((size_t)((R >> 6) * 2 + (up ? 0 : 1)) * 3) * ld + ch0;
#pragma unroll
                        for (int h4 = 0; h4 < 2; ++h4) { const f32x4 pv = {t[4 * h4], t[4 * h4 + 1], t[4 * h4 + 2], t[4 * h4 + 3]};
                            *(f32x4*)(hp + 4 * h4) = pv; *(f32x4*)(hp + ld + 4 * h4) = acc[ai][1][m][h4]; *(f32x4*)(hp + 2 * ld + 4 * h4) = acc[ai][0][m][h4]; } } }
            } }
    }
};

template <class Epi, class Sched, bool ALIGN_EPI = false, bool SP2 = false>
__device__ __forceinline__ void gemm_phase(PG8_LAS unsigned char* lds, const Gemm g, const Sched& S, const Epi& E) {
    const int tid = threadIdx.x, wid = __builtin_amdgcn_readfirstlane(tid >> 6), lane = tid & 63, wr = wid >> 2, wc = wid & 3, fr = lane & 15, fq = lane >> 4;
    const int K = g.K, nt = K / BK;
    unsigned voffA[2], voffB[2];
#pragma unroll
    for (int i = 0; i < 2; ++i) { int R, C; stage_rc(tid * 16 + i * 8192, R, C); const int Rb = Epi::PERM ? ((R & ~31) + perm32(R & 31)) : R;
        voffA[i] = (unsigned)(R * K + C) * 2u; voffB[i] = (unsigned)(Rb * K + C) * 2u; }
    const size_t kstep = (size_t)(BK * 2);
    const size_t hstep = (size_t)HALF * K * 2;
    const size_t tstep = 2 * hstep;
    const unsigned ldsw = (unsigned)wid * 1024u;
    const int aoff = lds_byte(wr * 64 + fr, fq * 8), boff = lds_byte(wc * 32 + fr, fq * 8);
#define PG8_SA(b, h) (((b) * 2 + (h)) * HTB)
#define PG8_SB(b, h) ((4 + (b) * 2 + (h)) * HTB)
#define PG8_STAGE(bufoff, gbase, voff) do { _Pragma("unroll") for (int _i = 0; _i < 2; ++_i) \
        __builtin_amdgcn_global_load_lds((const unsigned*)((const char*)(gbase) + (voff)[_i]), (PG8_LAS unsigned*)(lds + (bufoff) + ldsw + _i * 8192), 16, 0, 0); } while (0)
#define PG8_LDA(dst, b, h) do { _Pragma("unroll") for (int m = 0; m < 4; ++m) _Pragma("unroll") for (int k = 0; k < 2; ++k) dst[m][k] = *(const PG8_LAS bf16x8*)(lds + PG8_SA(b, h) + aoff + m * 2048 + k * 1024); } while (0)
#define PG8_LDB(dst, b, h) do { _Pragma("unroll") for (int n = 0; n < 2; ++n) _Pragma("unroll") for (int k = 0; k < 2; ++k) dst[n][k] = *(const PG8_LAS bf16x8*)(lds + PG8_SB(b, h) + boff + n * 2048 + k * 1024); } while (0)
#define PG8_MMA(ai, bj, At, Bt) do { __builtin_amdgcn_s_setprio(1); _Pragma("unroll") for (int m = 0; m < 4; ++m) _Pragma("unroll") for (int n = 0; n < 2; ++n) _Pragma("unroll") for (int k = 0; k < 2; ++k) \
        acc[ai][bj][m][n] = __builtin_amdgcn_mfma_f32_16x16x32_bf16(Bt[n][k], At[m][k], acc[ai][bj][m][n], 0, 0, 0); __builtin_amdgcn_s_setprio(0); } while (0)
#define PG8_WAIT_V(n) asm volatile("s_waitcnt vmcnt(" #n ")" ::: "memory")
#define PG8_WAIT_L(n) asm volatile("s_waitcnt lgkmcnt(" #n ")" ::: "memory")
#define PG8_BAR __builtin_amdgcn_s_barrier()
#define PG8_SCHED __builtin_amdgcn_sched_barrier(0)
    Unit cur, nxt; int ui = 0;
    if (!S.next(0, cur)) return;
    f32x4 acc[2][2][4][2];
#pragma unroll
    for (int a = 0; a < 2; ++a)
#pragma unroll
        for (int b = 0; b < 2; ++b)
#pragma unroll
            for (int m = 0; m < 4; ++m)
#pragma unroll
                for (int n = 0; n < 2; ++n) acc[a][b][m][n] = (f32x4){0.f, 0.f, 0.f, 0.f};
    bf16x8 At[4][2], B0[2][2], B1[2][2];
    const char* cA = (const char*)g.A + (size_t)cur.pm * tstep; const char* cB = (const char*)g.Bt + (size_t)cur.pn * tstep;
    S.a_ready(cur);
    if constexpr (SP2) {
        PG8_STAGE(PG8_SB(0, 0), cB, voffB); PG8_STAGE(PG8_SB(0, 1), cB + hstep, voffB); PG8_STAGE(PG8_SA(0, 0), cA, voffA); PG8_STAGE(PG8_SA(0, 1), cA + hstep, voffA);
        if (wr == 1) PG8_BAR;
        PG8_WAIT_V(2); PG8_BAR;
        PG8_STAGE(PG8_SB(1, 0), cB + kstep, voffB); PG8_STAGE(PG8_SA(1, 0), cA + kstep, voffA); PG8_STAGE(PG8_SB(1, 1), cB + hstep + kstep, voffB);
        PG8_WAIT_V(6); PG8_BAR;
    } else {
        PG8_STAGE(PG8_SB(0, 0), cB, voffB); PG8_STAGE(PG8_SA(0, 0), cA, voffA); PG8_STAGE(PG8_SB(0, 1), cB + hstep, voffB); PG8_STAGE(PG8_SA(0, 1), cA + hstep, voffA);
        if (wr == 1) PG8_BAR;
        PG8_WAIT_V(4); PG8_BAR;
        PG8_STAGE(PG8_SB(1, 0), cB + kstep, voffB); PG8_STAGE(PG8_SA(1, 0), cA + kstep, voffA); PG8_STAGE(PG8_SB(1, 1), cB + hstep + kstep, voffB);
        PG8_WAIT_V(6); PG8_BAR;
    }
    for (;;) {
        const bool has_next = S.next(ui + 1, nxt);
        const char* nA = has_next ? (const char*)g.A + (size_t)nxt.pm * tstep : cA; const char* nB = has_next ? (const char*)g.Bt + (size_t)nxt.pn * tstep : cB;
        for (int t = 0; t < nt; t += 2) {
            const bool last = (t == nt - 2);
            const char* a1 = cA + (size_t)(t + 1) * kstep;
            const char* a2 = last ? nA : cA + (size_t)(t + 2) * kstep; const char* b2 = last ? nB : cB + (size_t)(t + 2) * kstep;
            const char* a3 = a2 + kstep; const char* b3 = b2 + kstep;
            if (last && has_next) S.a_ready(nxt);
            if constexpr (SP2) {
            PG8_LDB(B0, 0, 0); PG8_LDB(B1, 0, 1); PG8_SCHED; PG8_LDA(At, 0, 0); PG8_STAGE(PG8_SA(1, 1), a1 + hstep, voffA);
            PG8_WAIT_V(8); PG8_WAIT_L(0); PG8_BAR; PG8_MMA(0, 0, At, B0); PG8_MMA(0, 1, At, B1); PG8_BAR; PG8_SCHED;
            PG8_LDA(At, 0, 1); PG8_STAGE(PG8_SB(0, 0), b2, voffB); PG8_STAGE(PG8_SB(0, 1), b2 + hstep, voffB); PG8_STAGE(PG8_SA(0, 0), a2, voffA);
            PG8_WAIT_V(8); PG8_WAIT_L(0); PG8_BAR; PG8_MMA(1, 0, At, B0); PG8_MMA(1, 1, At, B1); PG8_BAR; PG8_SCHED;
            PG8_LDB(B0, 1, 0); PG8_LDB(B1, 1, 1); PG8_SCHED; PG8_LDA(At, 1, 0); PG8_STAGE(PG8_SA(0, 1), a2 + hstep, voffA);
            PG8_WAIT_V(8); PG8_WAIT_L(0); PG8_BAR; PG8_MMA(0, 0, At, B0); PG8_MMA(0, 1, At, B1); PG8_BAR; PG8_SCHED;
            PG8_LDA(At, 1, 1); PG8_STAGE(PG8_SB(1, 0), b3, voffB); PG8_STAGE(PG8_SB(1, 1), b3 + hstep, voffB); PG8_STAGE(PG8_SA(1, 0), a3, voffA);
            PG8_WAIT_V(8); PG8_WAIT_L(0); PG8_BAR; PG8_MMA(1, 0, At, B0); PG8_MMA(1, 1, At, B1); PG8_BAR; PG8_SCHED;
            } else {
            PG8_LDB(B0, 0, 0); PG8_SCHED; PG8_LDA(At, 0, 0); PG8_STAGE(PG8_SA(1, 1), a1 + hstep, voffA);
            PG8_WAIT_L(8); PG8_BAR; PG8_WAIT_L(0); PG8_MMA(0, 0, At, B0); PG8_BAR; PG8_SCHED;
            PG8_LDB(B1, 0, 1); PG8_STAGE(PG8_SB(0, 0), b2, voffB);
            PG8_BAR; PG8_WAIT_L(0); PG8_MMA(0, 1, At, B1); PG8_BAR;
            PG8_LDA(At, 0, 1); PG8_STAGE(PG8_SA(0, 0), a2, voffA);
            PG8_BAR; PG8_WAIT_L(0); PG8_MMA(1, 0, At, B0); PG8_BAR; PG8_SCHED;
            PG8_STAGE(PG8_SB(0, 1), b2 + hstep, voffB);
            PG8_WAIT_V(6); PG8_BAR; PG8_MMA(1, 1, At, B1); PG8_BAR;
            PG8_LDB(B0, 1, 0); PG8_SCHED; PG8_LDA(At, 1, 0); PG8_STAGE(PG8_SA(0, 1), a2 + hstep, voffA);
            PG8_WAIT_L(8); PG8_BAR; PG8_WAIT_L(0); PG8_MMA(0, 0, At, B0); PG8_BAR; PG8_SCHED;
            PG8_LDB(B1, 1, 1); PG8_STAGE(PG8_SB(1, 0), b3, voffB);
            PG8_BAR; PG8_WAIT_L(0); PG8_MMA(0, 1, At, B1); PG8_BAR;
            PG8_LDA(At, 1, 1); PG8_STAGE(PG8_SA(1, 0), a3, voffA);
            PG8_BAR; PG8_WAIT_L(0); PG8_MMA(1, 0, At, B0); PG8_BAR; PG8_SCHED;
            PG8_STAGE(PG8_SB(1, 1), b3 + hstep, voffB);
            PG8_WAIT_V(6); PG8_BAR; PG8_MMA(1, 1, At, B1); PG8_BAR;
            }
        }
        if constexpr (ALIGN_EPI) { if (wr == 0) PG8_BAR; }
        if constexpr (!Epi::AFTER_DRAIN) { E(acc, cur, wr, wc, fr, fq); S.done(cur); }
        if (!has_next) break;
#pragma unroll
        for (int a = 0; a < 2; ++a)
#pragma unroll
            for (int b = 0; b < 2; ++b)
#pragma unroll
                for (int m = 0; m < 4; ++m)
#pragma unroll
                    for (int n = 0; n < 2; ++n) acc[a][b][m][n] = (f32x4){0.f, 0.f, 0.f, 0.f};
        cur = nxt; cA = nA; cB = nB; ++ui;
        if constexpr (ALIGN_EPI) { if (wr == 1) PG8_BAR; }
    }
    PG8_WAIT_V(0);
    if constexpr (!ALIGN_EPI) { if (wr == 0) PG8_BAR; }
    PG8_BAR;
    if constexpr (Epi::AFTER_DRAIN) { E.fused(acc, cur, wr, wc, fr, fq, lds, wid, lane); S.done(cur); }
#undef PG8_SA
#undef PG8_SB
#undef PG8_STAGE
#undef PG8_LDA
#undef PG8_LDB
#undef PG8_MMA
#undef PG8_WAIT_V
#undef PG8_WAIT_L
#undef PG8_BAR
#undef PG8_SCHED
}
}

constexpr int NWAVES = 8;
constexpr int N_LAUNCHES = MK_N_LAUNCHES;
constexpr int N_PHASES = 11;
constexpr int DM = 4096, SEQ = 8192, CTXL = 256, GW = 64, GROWS = 128, HD = 128;
constexpr int AW = 2048, NAW = 2048, NHEADS = 16, KH = 8, KW = 16;
constexpr int INC = 10240, KVS = 6144, DFF = 11008, ADA = 6 * DM;
constexpr int MROWS = SEQ + CTXL;
constexpr float EPS = 1e-6f;
constexpr int GEMV_KS = 64;
constexpr size_t MiB = 1u << 20;
constexpr size_t WS_CTL = 0, CTL_ZERO_BYTES = 1 * MiB;
constexpr size_t WS_WIN = 2 * MiB;
constexpr size_t WS_WOUT = 82 * MiB;
constexpr size_t WS_WUP = 114 * MiB;
constexpr size_t WS_WDN = 286 * MiB;
constexpr size_t WS_H = 372 * MiB;
constexpr size_t WS_U = 438 * MiB, SEG_BYTES = 32 * MiB;
constexpr size_t WS_KC = 598 * MiB, WS_VC = 599 * MiB;
constexpr size_t WS_Y = 600 * MiB;
constexpr size_t WS_AB = 664 * MiB, WS_GB = 836 * MiB;
constexpr size_t WS_ACT = 1008 * MiB;
constexpr size_t WS_PART = 1180 * MiB;
constexpr size_t WS_ADA = 1192 * MiB;
constexpr size_t WS_VST = 1193 * MiB;
constexpr size_t WS_END = 1196 * MiB;
constexpr int CW_BAR = 4096;
constexpr int RING_OFF = 0, RING_BYTES = 131072;
constexpr int LDSCTL_OFF = RING_BYTES, MISC_OFF = LDSCTL_OFF + 320;
constexpr int LDS_BYTES = 147456;
static_assert(MISC_OFF + 128 <= LDS_BYTES, "LDS map");

#define GAS __attribute__((address_space(1)))
#define LAS __attribute__((address_space(3)))
typedef unsigned short bf16;
typedef unsigned v4u __attribute__((ext_vector_type(4)));
typedef unsigned v2u __attribute__((ext_vector_type(2)));
typedef float f32x4 __attribute__((ext_vector_type(4)));
typedef float f32x2 __attribute__((ext_vector_type(2)));
typedef short bf16x8 __attribute__((ext_vector_type(8)));
typedef short s16x4 __attribute__((ext_vector_type(4)));
typedef short v4i16_t __attribute__((ext_vector_type(4)));
typedef GAS unsigned gu32;
#define RLX_AGENT __ATOMIC_RELAXED, __HIP_MEMORY_SCOPE_AGENT
#define LDS_WAIT() asm volatile("s_waitcnt lgkmcnt(0)" ::: "memory")
#define VM_WAIT() asm volatile("s_waitcnt vmcnt(0)" ::: "memory")
using pg8::cvtpk; using pg8::gelu_t; using pg8::silu_f;
__device__ __forceinline__ float bf_lo(unsigned w) { return __uint_as_float(w << 16); }
__device__ __forceinline__ float bf_hi(unsigned w) { return __uint_as_float(w & 0xffff0000u); }
__device__ __forceinline__ s16x4 vtr(const LAS unsigned char* p) { return __builtin_bit_cast(s16x4, __builtin_amdgcn_ds_read_tr16_b64_v4i16((LAS v4i16_t*)p)); }
__device__ __forceinline__ float wave_sum(float v) {
#pragma unroll
    for (int o = 1; o < 64; o <<= 1) v += __shfl_xor(v, o);
    return v;
}
#define XB_TMO      128
#define XB_XCNT(j)  (256  + 64 * (j))
#define XB_XSUB(j)  (1280 + 64 * (j))
#define XB_XGEN(j)  (2304 + 64 * (j))
#define XB_TOP      3328
#define XB_TOPGEN   3392
#define XCD_BAR_WORDS 3456
#define XB_SPIN_CAP (1u << 18)

__device__ __forceinline__ unsigned xb_ld(unsigned* p)              { return __hip_atomic_load(p, __ATOMIC_RELAXED, __HIP_MEMORY_SCOPE_AGENT); }
__device__ __forceinline__ unsigned xb_add(unsigned* p, unsigned v) { return __hip_atomic_fetch_add(p, v, __ATOMIC_RELAXED, __HIP_MEMORY_SCOPE_AGENT); }
__device__ __forceinline__ unsigned xb_xcc_id() { return (unsigned)__builtin_amdgcn_s_getreg((3 << 11) | 20) & 0xFu; }
#define XB_SPIN(cond, bar) do { unsigned _sp = 0; while (cond) { __builtin_amdgcn_s_sleep(1); \
    if ((++_sp & 255u) == 0u) { if (xb_ld(&(bar)[XB_TMO])) break; if (_sp > XB_SPIN_CAP) { atomicAdd(&(bar)[XB_TMO], 1u); break; } } } } while (0)

struct XcdBarrier {
    unsigned* bar; unsigned x;
    volatile LAS unsigned* st;
};

__device__ __forceinline__ XcdBarrier xcd_barrier_post(unsigned* bar, volatile LAS unsigned* st) {
    XcdBarrier b; b.bar = bar; b.x = xb_xcc_id(); b.st = st;
    if (threadIdx.x == 0) (void)xb_add(&bar[XB_XCNT(b.x)], 1u);
    return b;
}
__device__ __forceinline__ void xcd_barrier_complete(unsigned* bar, unsigned x, unsigned& nloc, unsigned& nx) {
    const unsigned G = gridDim.x * gridDim.y * gridDim.z;
    unsigned sum, cnt, mine, sp = 0u;
    for (;;) {
        sum = 0u; cnt = 0u; mine = 0u;
#pragma unroll
        for (unsigned j = 0; j < 16; ++j) { const unsigned c = xb_ld(&bar[XB_XCNT(j)]); sum += c; cnt += (c > 0u) ? 1u : 0u; mine = (j == x) ? c : mine; }
        if (sum == G) break;
        __builtin_amdgcn_s_sleep(1);
        if ((++sp & 255u) == 0u) { if (xb_ld(&bar[XB_TMO])) break; if (sp > XB_SPIN_CAP) { atomicAdd(&bar[XB_TMO], 1u); break; } }
    }
    nloc = mine > 0u ? mine : 1u; nx = cnt > 0u ? cnt : 1u;
}

__device__ __forceinline__ void xcd_barrier(const XcdBarrier& b) {
    asm volatile("s_waitcnt vmcnt(0)" ::: "memory");
    __syncthreads();
    if (threadIdx.x == 0) {
        unsigned* bar = b.bar;
        __builtin_amdgcn_s_waitcnt(0);
        unsigned nloc = b.st[0], nx = b.st[1];
        if (nloc == 0u) { xcd_barrier_complete(bar, b.x, nloc, nx); b.st[0] = nloc; b.st[1] = nx; }
        const unsigned old = xb_add(&bar[XB_XSUB(b.x)], 1u);
        const unsigned gen = old / nloc;
        if (old + 1u == (gen + 1u) * nloc) {
            __builtin_amdgcn_fence(__ATOMIC_RELEASE, "agent");
            asm volatile("s_waitcnt vmcnt(0)" ::: "memory");
            const unsigned og = xb_add(&bar[XB_TOP], 1u);
            const unsigned tg = og / nx;
            if (og + 1u == (tg + 1u) * nx) xb_add(&bar[XB_TOPGEN], 1u);
            else XB_SPIN(xb_ld(&bar[XB_TOPGEN]) == tg, bar);
            __builtin_amdgcn_fence(__ATOMIC_ACQUIRE, "agent");
            xb_add(&bar[XB_XGEN(b.x)], 1u);
            asm volatile("s_waitcnt vmcnt(0)" ::: "memory");
        } else {
            XB_SPIN(xb_ld(&bar[XB_XGEN(b.x)]) == gen, bar);
            __builtin_amdgcn_fence(__ATOMIC_ACQUIRE, "agent");
            asm volatile("s_waitcnt vmcnt(0)" ::: "memory");
        }
    }
    __syncthreads();
}

struct Frame {
    LAS unsigned char* lds;
    volatile LAS unsigned* MISC;
    gu32* ctl;
    int tid, lane, wave;
    int vcu, G;
    const float *x, *cvec, *ctx, *cctx, *w_ada, *b_ada, *g1, *w_in, *ln_g, *ln_b, *w_s, *b_s, *rpb, *w_out, *g2, *w_up, *conv_w, *conv_b, *w_down, *g_final;
    float* out;
    bf16 *WIN, *WOUT, *WUP, *WDN, *H, *U, *V, *Q, *K, *VA, *KC, *VC, *Y, *AB, *GB, *ACT;
    float *PART, *ADAV, *VST, *HALO;
};

__device__ __forceinline__ void tr_item(const float* W, int K, int N, bf16* WT, int k0, int n0, int drow0, LAS float* scr, int lane) {
#pragma unroll 8
    for (int i = 0; i < 32; ++i) { const int kk = 2 * i + (lane >> 5); scr[kk * 33 + (lane & 31)] = W[(size_t)(k0 + kk) * N + n0 + (lane & 31)]; }
    LDS_WAIT(); asm volatile("" ::: "memory");
    const int c = lane & 7;
#pragma unroll
    for (int j = 0; j < 4; ++j) { const int n = (lane >> 3) + 8 * j; const LAS float* s = scr + (8 * c) * 33 + n;
        v4u o; o.x = cvtpk(s[0 * 33], s[1 * 33]); o.y = cvtpk(s[2 * 33], s[3 * 33]); o.z = cvtpk(s[4 * 33], s[5 * 33]); o.w = cvtpk(s[6 * 33], s[7 * 33]);
        *(GAS v4u*)(WT + (size_t)(drow0 + n) * K + k0 + 8 * c) = o; }
    LDS_WAIT(); asm volatile("" ::: "memory");
}
__device__ __forceinline__ void gemv_item(Frame& F, int item) {
    const int cc = item % 96, ks = item / 96, k0 = ks * 64;
    const float s0v = silu_f(F.cvec[k0 + F.lane]), s1v = silu_f(F.cctx[k0 + F.lane]);
    const GAS float* W = (const GAS float*)F.w_ada + (size_t)k0 * ADA + cc * 256 + 4 * F.lane;
    f32x4 a0 = {0.f, 0.f, 0.f, 0.f}, a1 = {0.f, 0.f, 0.f, 0.f};
#pragma unroll 8
    for (int kk = 0; kk < 64; ++kk) {
        const f32x4 w = *(const GAS f32x4*)(W + (size_t)kk * ADA);
        const float s0 = __uint_as_float(__builtin_amdgcn_readlane(__float_as_uint(s0v), kk));
        const float s1 = __uint_as_float(__builtin_amdgcn_readlane(__float_as_uint(s1v), kk));
        a0 += w * s0; a1 += w * s1;
    }
    GAS float* P = (GAS float*)F.PART + ((size_t)ks * 2) * ADA + cc * 256 + 4 * F.lane;
    *(GAS f32x4*)P = a0; *(GAS f32x4*)(P + ADA) = a1;
}
__device__ __forceinline__ void p0_phase(Frame& F) {
    LAS float* scr = (LAS float*)(F.lds + RING_OFF + F.wave * 16384);
    const int gw = F.vcu * NWAVES + F.wave, NGW = F.G * NWAVES;
    for (int it = gw; it < 96 * GEMV_KS; it += NGW) gemv_item(F, it);
    constexpr int NB_IN = INC / 32, I_IN = (DM / 64) * NB_IN;
    for (int it = gw; it < I_IN; it += NGW) { const int kb = it / NB_IN, nb = it % NB_IN; tr_item(F.w_in, DM, INC, F.WIN, 64 * kb, 32 * nb, 32 * nb, scr, F.lane); }
}
__device__ __forceinline__ void p1_phase(Frame& F) {
    LAS float* scr = (LAS float*)(F.lds + RING_OFF + F.wave * 16384);
    const int gw = F.vcu * NWAVES + F.wave, NGW = F.G * NWAVES;
    for (int i = F.vcu * 512 + F.tid; i < 2 * ADA; i += F.G * 512) { const int v = i / ADA, n = i - v * ADA; float s = F.b_ada[n];
#pragma unroll 8
        for (int ks = 0; ks < GEMV_KS; ++ks) s += F.PART[((size_t)ks * 2 + v) * ADA + n];
        F.ADAV[i] = s; }
    constexpr int NB_O = DM / 32, I_O = (DM / 64) * NB_O;
    constexpr int NB_U = (2 * DFF) / 32, I_U = (DM / 64) * NB_U;
    constexpr int NB_D = DM / 32, I_D = (DFF / 64) * NB_D;
    for (int it = gw; it < I_O + I_U + I_D; it += NGW) {
        int r = it;
        if (r < I_O) { const int kb = r / NB_O, nb = r % NB_O; tr_item(F.w_out, DM, DM, F.WOUT, 64 * kb, 32 * nb, 32 * nb, scr, F.lane); continue; } r -= I_O;
        if (r < I_U) { const int kb = r / NB_U, nb = r % NB_U; const int n0 = 32 * nb; const int isg = n0 >= DFF ? 1 : 0; const int f = n0 - isg * DFF;
                       tr_item(F.w_up, DM, 2 * DFF, F.WUP, 64 * kb, n0, 256 * (f >> 7) + 128 * isg + (f & 127), scr, F.lane); continue; } r -= I_U;
        { const int kb = r / NB_D, nb = r % NB_D; tr_item(F.w_down, DFF, DM, F.WDN, 64 * kb, 32 * nb, 32 * nb, scr, F.lane); }
    }
}
template <bool F32OUT>
__device__ __forceinline__ void norm_rows(Frame& F, const float* src, void* dst, int nrows, const LAS float* TA, const LAS float* TB) {
    const int gw = F.vcu * NWAVES + F.wave, NGW = F.G * NWAVES;
    for (int row = gw; row < nrows; row += NGW) {
        const GAS f32x4* xr = (const GAS f32x4*)(src + (size_t)row * DM) + F.lane;
        f32x4 v[16]; float ss = 0.f;
#pragma unroll
        for (int j = 0; j < 16; ++j) { v[j] = xr[64 * j]; ss += (v[j].x * v[j].x + v[j].y * v[j].y) + (v[j].z * v[j].z + v[j].w * v[j].w); }
        ss = wave_sum(ss);
        const float rstd = 1.0f / sqrtf(ss * (1.0f / DM) + EPS);
        if (F32OUT) { GAS f32x4* o = (GAS f32x4*)((float*)dst + (size_t)row * DM) + F.lane;
#pragma unroll
            for (int j = 0; j < 16; ++j) { const f32x4 a = *(const LAS f32x4*)(TA + 4 * (F.lane + 64 * j)); o[64 * j] = v[j] * rstd * a; } }
        else { GAS v2u* o = (GAS v2u*)((bf16*)dst + (size_t)row * DM) + F.lane;
#pragma unroll
            for (int j = 0; j < 16; ++j) { const f32x4 a = *(const LAS f32x4*)(TA + 4 * (F.lane + 64 * j)), b = *(const LAS f32x4*)(TB + 4 * (F.lane + 64 * j));
                const f32x4 y = v[j] * rstd * a + b; v2u w; w.x = cvtpk(y.x, y.y); w.y = cvtpk(y.z, y.w); o[64 * j] = w; } }
    }
}
__device__ __forceinline__ void build_tables(Frame& F, const float* g, const float* scale, const float* shift, LAS float* TA, LAS float* TB) {
    for (int i = F.tid; i < DM; i += NWAVES * 64) { TA[i] = scale ? g[i] * (1.0f + scale[i]) : g[i]; TB[i] = shift ? shift[i] : 0.f; }
    LDS_WAIT(); __syncthreads();
}
__device__ __forceinline__ void ctx_kv(Frame& F) {
    for (int b = F.vcu; b < 256; b += F.G) {
        const int tm = b >> 6, tn = b & 63, wm = F.wave >> 2, wn = F.wave & 3, g = F.lane >> 4, qi = F.lane & 15;
        const GAS bf16* Ap = (const GAS bf16*)F.H + (size_t)(SEQ + 64 * tm + 32 * wm + qi) * DM + 8 * g;
        const GAS bf16* Bp = (const GAS bf16*)F.WIN + (size_t)(KVS + 64 * tn + 16 * wn + qi) * DM + 8 * g;
        f32x4 acc0 = {0.f, 0.f, 0.f, 0.f}, acc1 = {0.f, 0.f, 0.f, 0.f};
#pragma unroll 4
        for (int k = 0; k < DM; k += 32) {
            const bf16x8 a0 = *(const GAS bf16x8*)(Ap + k), a1 = *(const GAS bf16x8*)(Ap + (size_t)16 * DM + k), bb = *(const GAS bf16x8*)(Bp + k);
            acc0 = __builtin_amdgcn_mfma_f32_16x16x32_bf16(a0, bb, acc0, 0, 0, 0);
            acc1 = __builtin_amdgcn_mfma_f32_16x16x32_bf16(a1, bb, acc1, 0, 0, 0);
        }
        const int col = 64 * tn + 16 * wn + qi;
        GAS bf16* dst = (GAS bf16*)(col < NAW ? F.KC : F.VC) + (col & (NAW - 1));
        const int rbase = 64 * tm + 32 * wm + 4 * g;
#pragma unroll
        for (int j = 0; j < 4; ++j) { dst[(size_t)(rbase + j) * NAW] = (bf16)(cvtpk(acc0[j], 0.f) & 0xffffu); dst[(size_t)(rbase + 16 + j) * NAW] = (bf16)(cvtpk(acc1[j], 0.f) & 0xffffu); }
    }
}
constexpr int GM_STAT = 0, GM_WS = 1024, GM_WS_STRIDE = 272, GM_VLN = GM_WS + 128 * GM_WS_STRIDE, GM_VLN_STRIDE = 288, GM_END = GM_VLN + 128 * GM_VLN_STRIDE;
static_assert(GM_END <= RING_BYTES, "gMLP LDS");
__device__ __forceinline__ void gmlp_unit(Frame& F, int c, int gch) {
    LAS unsigned char* L = F.lds + RING_OFF;
    LAS f32x2* STAT = (LAS f32x2*)(L + GM_STAT);
    const int tid = F.tid, lane = F.lane, g = lane >> 4, qi = lane & 15;
    if (tid < 128) { const GAS f32x2* p = (const GAS f32x2*)F.VST + (size_t)(128 * c + tid) * 32; float s = 0.f, s2 = 0.f;
#pragma unroll 8
        for (int i = 0; i < 32; ++i) { const f32x2 t = p[i]; s += t.x; s2 += t.y; }
        const float mean = s * (1.0f / AW), var = s2 * (1.0f / AW) - mean * mean; f32x2 st = {mean, 1.0f / sqrtf(var + EPS)}; STAT[tid] = st; }
#pragma unroll
    for (int i = 0; i < 8; ++i) { const int idx = tid + 512 * i, p = idx >> 5, q4 = idx & 31;
        const f32x4 w = *(const GAS f32x4*)(F.w_s + ((size_t)gch * 128 + p) * 128 + 4 * q4);
        v2u o; o.x = cvtpk(w.x, w.y); o.y = cvtpk(w.z, w.w); *(LAS v2u*)(L + GM_WS + p * GM_WS_STRIDE + 8 * q4) = o; }
    LDS_WAIT(); __syncthreads();
    { const int ch8 = tid & 15; const int cb = gch * 128 + 8 * ch8;
      const f32x4 lg0 = *(const GAS f32x4*)(F.ln_g + cb), lg1 = *(const GAS f32x4*)(F.ln_g + cb + 4), lb0 = *(const GAS f32x4*)(F.ln_b + cb), lb1 = *(const GAS f32x4*)(F.ln_b + cb + 4);
#pragma unroll
      for (int i = 0; i < 4; ++i) { const int q = (tid >> 4) + 32 * i;
          const v4u raw = *(const GAS v4u*)(F.V + (size_t)(128 * c + q) * AW + cb);
          const f32x2 st = STAT[q]; const float mu = st.x, rs = st.y;
          v4u o;
          o.x = cvtpk((bf_lo(raw.x) - mu) * rs * lg0.x + lb0.x, (bf_hi(raw.x) - mu) * rs * lg0.y + lb0.y);
          o.y = cvtpk((bf_lo(raw.y) - mu) * rs * lg0.z + lb0.z, (bf_hi(raw.y) - mu) * rs * lg0.w + lb0.w);
          o.z = cvtpk((bf_lo(raw.z) - mu) * rs * lg1.x + lb1.x, (bf_hi(raw.z) - mu) * rs * lg1.y + lb1.y);
          o.w = cvtpk((bf_lo(raw.w) - mu) * rs * lg1.z + lb1.z, (bf_hi(raw.w) - mu) * rs * lg1.w + lb1.w);
          *(LAS v4u*)(L + GM_VLN + q * GM_VLN_STRIDE + 16 * ch8) = o; } }
    LDS_WAIT(); __syncthreads();
    f32x4 acc[8];
#pragma unroll
    for (int nf = 0; nf < 8; ++nf) acc[nf] = (f32x4){0.f, 0.f, 0.f, 0.f};
    const LAS unsigned char* va = L + GM_VLN + (4 * g + (qi >> 2)) * GM_VLN_STRIDE + 32 * F.wave + 8 * (qi & 3);
    const LAS unsigned char* wa = L + GM_WS + qi * GM_WS_STRIDE + 8 * g;
#pragma unroll
    for (int kb = 0; kb < 4; ++kb) {
        const s16x4 lo = vtr(va + kb * 32 * GM_VLN_STRIDE), hi = vtr(va + (kb * 32 + 16) * GM_VLN_STRIDE);
        const bf16x8 af = (bf16x8){lo[0], lo[1], lo[2], lo[3], hi[0], hi[1], hi[2], hi[3]};
#pragma unroll
        for (int nf = 0; nf < 8; ++nf) {
            const s16x4 b0 = *(const LAS s16x4*)(wa + nf * 16 * GM_WS_STRIDE + kb * 64), b1 = *(const LAS s16x4*)(wa + nf * 16 * GM_WS_STRIDE + kb * 64 + 32);
            const bf16x8 bfr = (bf16x8){b0[0], b0[1], b0[2], b0[3], b1[0], b1[1], b1[2], b1[3]};
            acc[nf] = __builtin_amdgcn_mfma_f32_16x16x32_bf16(af, bfr, acc[nf], 0, 0, 0);
        }
    }
#pragma unroll
    for (int nf = 0; nf < 8; ++nf) { const int p = 16 * nf + qi; const size_t row = (size_t)(128 * c + p); const int col = 128 * gch + 16 * F.wave + 4 * g;
        const float bs = F.b_s[gch * 128 + p];
        const v2u gu = *(const GAS v2u*)(F.U + row * AW + col);
        v2u o; o.x = cvtpk(bf_lo(gu.x) * (acc[nf][0] + bs), bf_hi(gu.x) * (acc[nf][1] + bs)); o.y = cvtpk(bf_lo(gu.y) * (acc[nf][2] + bs), bf_hi(gu.y) * (acc[nf][3] + bs));
        *(GAS v2u*)(F.Y + row * DM + col) = o; }
    LDS_WAIT(); __syncthreads();
}
constexpr int NAK_STRIDE = 272, NAV_STRIDE = 288, NA_KBUF = 64 * NAK_STRIDE, NA_VBUF = 64 * NAV_STRIDE, NA_BUF = NA_KBUF + NA_VBUF;
static_assert(2 * NA_BUF <= RING_BYTES, "NA LDS");
__device__ __forceinline__ void na_wg_unit(Frame& F, int h, int rp) {
    LAS unsigned char* L = F.lds + RING_OFF;
    const int tid = F.tid, lane = F.lane, g = lane >> 4, qi = lane & 15;
    const int ri = F.wave >> 2, jb = F.wave & 3, r = 2 * rp + ri;
    const int r0 = min(max(r - KH / 2, 0), GROWS - KH);
    const int kr_lo = min(max(2 * rp - KH / 2, 0), GROWS - KH), kr_hi = min(max(2 * rp + 1 - KH / 2, 0), GROWS - KH) + KH - 1;
    const int nsteps = 4 + (kr_hi - kr_lo + 1);
    const int qc = 16 * jb + qi, tq = GW * r + qc;
    const int c0 = min(max(qc - KW / 2, 0), GW - KW);
    const float SCALE = 0.08838834764831845f, L2E = 1.4426950408889634f;
    const GAS bf16* Qp = (const GAS bf16*)F.Q + (size_t)tq * NAW + h * HD + 8 * g;
    bf16x8 qf[4];
#pragma unroll
    for (int s = 0; s < 4; ++s) qf[s] = *(const GAS bf16x8*)(Qp + 32 * s);
    f32x4 o[8];
#pragma unroll
    for (int nf = 0; nf < 8; ++nf) o[nf] = (f32x4){0.f, 0.f, 0.f, 0.f};
    float m = -1e30f, l = 0.f;
    const int lrow = tid >> 4, lch = tid & 15;
    const size_t lofs = (size_t)lrow * NAW + h * HD + 8 * lch;
    const int kw_off = lrow * NAK_STRIDE + 16 * lch, vw_off = NA_KBUF + lrow * NAV_STRIDE + 16 * lch;
    v4u kreg[2], vreg[2];
    { const GAS bf16* Kb = (const GAS bf16*)F.KC + lofs; const GAS bf16* Vb = (const GAS bf16*)F.VC + lofs;
#pragma unroll
      for (int i = 0; i < 2; ++i) { kreg[i] = *(const GAS v4u*)(Kb + (size_t)32 * i * NAW); vreg[i] = *(const GAS v4u*)(Vb + (size_t)32 * i * NAW); }
#pragma unroll
      for (int i = 0; i < 2; ++i) { *(LAS v4u*)(L + kw_off + 32 * i * NAK_STRIDE) = kreg[i]; *(LAS v4u*)(L + vw_off + 32 * i * NAV_STRIDE) = vreg[i]; }
      LDS_WAIT(); __syncthreads(); }
    const int ka_off = qi * NAK_STRIDE + 16 * g;
    const int tr_off = NA_KBUF + (4 * g + (qi >> 2)) * NAV_STRIDE + 8 * (qi & 3);
#pragma unroll 1
    for (int st = 0; st < nsteps; ++st) {
        const bool more = st + 1 < nsteps;
        if (more) { const int s1 = st + 1; const GAS bf16 *Kb, *Vb;
            if (s1 < 4) { Kb = (const GAS bf16*)F.KC + (size_t)(64 * s1) * NAW + lofs; Vb = (const GAS bf16*)F.VC + (size_t)(64 * s1) * NAW + lofs; }
            else { const size_t tok0 = (size_t)GW * (kr_lo + s1 - 4); Kb = (const GAS bf16*)F.K + tok0 * NAW + lofs; Vb = (const GAS bf16*)F.VA + tok0 * NAW + lofs; }
#pragma unroll
            for (int i = 0; i < 2; ++i) { kreg[i] = *(const GAS v4u*)(Kb + (size_t)32 * i * NAW); vreg[i] = *(const GAS v4u*)(Vb + (size_t)32 * i * NAW); } }
        const LAS unsigned char* B = L + (st & 1) * NA_BUF;
        const bool local = st >= 4; const int kr = kr_lo + st - 4;
        const bool active = !local || (kr >= r0 && kr < r0 + KH);
        if (active) {
            const int dr = kr - r + (KH - 1);
#pragma unroll
            for (int half = 0; half < 2; ++half) {
                if (local && ((jb == 0 && half == 1) || (jb == 3 && half == 0))) continue;
                const LAS unsigned char* Kt = B + ka_off + 32 * half * NAK_STRIDE;
                f32x4 s0 = {0.f, 0.f, 0.f, 0.f}, s1 = {0.f, 0.f, 0.f, 0.f};
#pragma unroll
                for (int s = 0; s < 4; ++s) {
                    const bf16x8 k0 = *(const LAS bf16x8*)(Kt + 64 * s), k1 = *(const LAS bf16x8*)(Kt + 16 * NAK_STRIDE + 64 * s);
                    s0 = __builtin_amdgcn_mfma_f32_16x16x32_bf16(k0, qf[s], s0, 0, 0, 0);
                    s1 = __builtin_amdgcn_mfma_f32_16x16x32_bf16(k1, qf[s], s1, 0, 0, 0);
                }
                float xs[8];
#pragma unroll
                for (int e = 0; e < 4; ++e) { xs[e] = s0[e] * SCALE; xs[4 + e] = s1[e] * SCALE; }
                if (local) {
#pragma unroll
                    for (int e = 0; e < 8; ++e) { const int kc = 32 * half + 16 * (e >> 2) + 4 * g + (e & 3); const bool valid = (kc >= c0) && (kc < c0 + KW);
                        const int dc = min(max(kc - qc + (KW - 1), 0), 2 * KW - 2);
                        const float bias = F.rpb[(h * (2 * KH - 1) + dr) * (2 * KW - 1) + dc];
                        xs[e] = valid ? xs[e] + bias : -INFINITY; }
                }
                float mx = fmaxf(fmaxf(fmaxf(xs[0], xs[1]), fmaxf(xs[2], xs[3])), fmaxf(fmaxf(xs[4], xs[5]), fmaxf(xs[6], xs[7])));
                mx = fmaxf(mx, __shfl_xor(mx, 16)); mx = fmaxf(mx, __shfl_xor(mx, 32));
                const float mn = fmaxf(m, mx), alpha = __builtin_amdgcn_exp2f((m - mn) * L2E);
                float ps = 0.f; float p[8];
#pragma unroll
                for (int e = 0; e < 8; ++e) { p[e] = __builtin_amdgcn_exp2f((xs[e] - mn) * L2E); ps += p[e]; }
                l = l * alpha + ps; m = mn;
#pragma unroll
                for (int nf = 0; nf < 8; ++nf) o[nf] = o[nf] * alpha;
                const v4u pw = {cvtpk(p[0], p[1]), cvtpk(p[2], p[3]), cvtpk(p[4], p[5]), cvtpk(p[6], p[7])};
                const bf16x8 pf = __builtin_bit_cast(bf16x8, pw);
                const LAS unsigned char* Vt = B + tr_off + 32 * half * NAV_STRIDE;
#pragma unroll
                for (int nf = 0; nf < 8; ++nf) {
                    const s16x4 lo = vtr(Vt + 32 * nf), hi = vtr(Vt + 16 * NAV_STRIDE + 32 * nf);
                    const bf16x8 vf = (bf16x8){lo[0], lo[1], lo[2], lo[3], hi[0], hi[1], hi[2], hi[3]};
                    o[nf] = __builtin_amdgcn_mfma_f32_16x16x32_bf16(vf, pf, o[nf], 0, 0, 0);
                }
            }
        }
        if (more) { LAS unsigned char* W = L + ((st + 1) & 1) * NA_BUF;
#pragma unroll
            for (int i = 0; i < 2; ++i) { *(LAS v4u*)(W + kw_off + 32 * i * NAK_STRIDE) = kreg[i]; *(LAS v4u*)(W + vw_off + 32 * i * NAV_STRIDE) = vreg[i]; } }
        LDS_WAIT(); __syncthreads();
    }
    l += __shfl_xor(l, 16); l += __shfl_xor(l, 32);
    const float inv = 1.0f / l;
    GAS bf16* Op = (GAS bf16*)F.Y + (size_t)tq * DM + AW + h * HD + 4 * g;
#pragma unroll
    for (int nf = 0; nf < 8; ++nf) { v2u w; w.x = cvtpk(o[nf][0] * inv, o[nf][1] * inv); w.y = cvtpk(o[nf][2] * inv, o[nf][3] * inv); *(GAS v2u*)(Op + 16 * nf) = w; }
}
__device__ __forceinline__ void conv_fix(Frame& F) {
    constexpr int NCG = DFF / 4, TOTAL = (SEQ / 64 - 1) * 2 * NCG;
    for (int it = F.vcu * 512 + F.tid; it < TOTAL; it += F.G * 512) {
        const int cg = it % NCG, rem = it / NCG, side = rem & 1, bd = 1 + (rem >> 1), f = 4 * cg;
        const GAS float* H0 = (const GAS float*)F.HALO + ((size_t)(bd * 2 + 0) * 3) * DFF + f; const GAS float* H1 = (const GAS float*)F.HALO + ((size_t)(bd * 2 + 1) * 3) * DFF + f;
        const GAS float* Hm = side ? H1 : H0; const GAS float* Ho = side ? H0 : H1;
        const f32x4 P = *(const GAS f32x4*)Hm, gg = *(const GAS f32x4*)(Hm + DFF), ao = *(const GAS f32x4*)(Ho + 2 * DFF);
        const f32x4 w = *(const GAS f32x4*)((const GAS float*)F.conv_w + (side ? 0 : 2 * DFF) + f);
        const f32x4 t = P + w * ao;
        const int row = 64 * bd - 1 + side;
        v2u o; o.x = cvtpk(silu_f(t.x) * gg.x, silu_f(t.y) * gg.y); o.y = cvtpk(silu_f(t.z) * gg.z, silu_f(t.w) * gg.w);
        *(GAS v2u*)((GAS bf16*)F.ACT + (size_t)row * DFF + f) = o;
    }
}

struct Args { const float* in[20]; float* out; unsigned char* ws; int ph_lo, ph_hi; };
__global__ void __launch_bounds__(NWAVES * 64, 2) mk_fwd(Args args) {
    extern __shared__ __attribute__((aligned(16))) unsigned char lds[];
    Frame F;
    F.lds = (LAS unsigned char*)lds;
    F.MISC = (volatile LAS unsigned*)(F.lds + MISC_OFF);
    F.tid = threadIdx.x; F.lane = F.tid & 63; F.wave = __builtin_amdgcn_readfirstlane(F.tid >> 6);
    F.G = gridDim.x; { const int bx = blockIdx.x; F.vcu = (F.G % 8 == 0) ? (bx % 8) * (F.G / 8) + bx / 8 : bx; }
    unsigned char* ws = args.ws;
    F.ctl = (gu32*)(ws + WS_CTL);
    F.x = args.in[0]; F.cvec = args.in[1]; F.ctx = args.in[2]; F.cctx = args.in[3]; F.w_ada = args.in[4]; F.b_ada = args.in[5]; F.g1 = args.in[6]; F.w_in = args.in[7];
    F.ln_g = args.in[8]; F.ln_b = args.in[9]; F.w_s = args.in[10]; F.b_s = args.in[11]; F.rpb = args.in[12]; F.w_out = args.in[13]; F.g2 = args.in[14]; F.w_up = args.in[15];
    F.conv_w = args.in[16]; F.conv_b = args.in[17]; F.w_down = args.in[18]; F.g_final = args.in[19]; F.out = args.out;
    F.WIN = (bf16*)(ws + WS_WIN); F.WOUT = (bf16*)(ws + WS_WOUT); F.WUP = (bf16*)(ws + WS_WUP); F.WDN = (bf16*)(ws + WS_WDN); F.H = (bf16*)(ws + WS_H);
    F.U = (bf16*)(ws + WS_U); F.V = (bf16*)(ws + WS_U + SEG_BYTES); F.Q = (bf16*)(ws + WS_U + 2 * SEG_BYTES); F.K = (bf16*)(ws + WS_U + 3 * SEG_BYTES); F.VA = (bf16*)(ws + WS_U + 4 * SEG_BYTES);
    F.KC = (bf16*)(ws + WS_KC); F.VC = (bf16*)(ws + WS_VC); F.Y = (bf16*)(ws + WS_Y); F.AB = (bf16*)(ws + WS_AB); F.GB = (bf16*)(ws + WS_GB); F.ACT = (bf16*)(ws + WS_ACT);
    F.PART = (float*)(ws + WS_PART); F.ADAV = (float*)(ws + WS_ADA); F.VST = (float*)(ws + WS_VST); F.HALO = (float*)(ws + WS_AB);
    for (int u = F.tid; u < (LDS_BYTES - LDSCTL_OFF) / 4; u += NWAVES * 64) ((LAS unsigned*)(F.lds + LDSCTL_OFF))[u] = 0u;
    __syncthreads();
    XcdBarrier bar; bar.bar = (unsigned*)(F.ctl + CW_BAR); bar.x = 0; bar.st = nullptr;
    if (N_LAUNCHES == 1) bar = xcd_barrier_post((unsigned*)(F.ctl + CW_BAR), F.MISC + 8);
#define GRID_BAR() do { if (N_LAUNCHES == 1) xcd_barrier(bar); } while (0)
    const int lo = args.ph_lo, hi = args.ph_hi;
#define IN(k) (lo <= (k) && (k) < hi)
#define BOTH(k) (IN(k) && IN((k) + 1))
    LAS float* TA = (LAS float*)(F.lds + RING_OFF); LAS float* TB = TA + DM;

    if (IN(0)) { p0_phase(F); if (BOTH(0)) GRID_BAR(); }
    if (IN(1)) { p1_phase(F); if (BOTH(1)) GRID_BAR(); }
    if (IN(2)) {
        build_tables(F, F.g1, F.ADAV + DM, F.ADAV, TA, TB);
        norm_rows<false>(F, F.x, F.H, SEQ, TA, TB);
        __syncthreads();
        build_tables(F, F.g1, F.ADAV + ADA + DM, F.ADAV + ADA, TA, TB);
        norm_rows<false>(F, F.ctx, F.H + (size_t)SEQ * DM, CTXL, TA, TB);
        __syncthreads();
        if (BOTH(2)) GRID_BAR();
    }
    if (IN(3)) {
        ctx_kv(F);
        VM_WAIT(); __syncthreads();
        pg8::Gemm g{F.H, F.WIN, SEQ, INC, DM}; pg8::StaticOrder S; S.init(SEQ, INC, F.G, (int)blockIdx.x);
        pg8::EpiIn E{F.U, (size_t)SEG_BYTES / 2, F.VST};
        pg8::gemm_phase<pg8::EpiIn, pg8::StaticOrder, true, true>(F.lds + RING_OFF, g, S, E);
        if (BOTH(3)) GRID_BAR();
    }
    if (IN(4)) {
        for (int uid = F.vcu; uid < 1024; uid += F.G) gmlp_unit(F, uid >> 4, uid & 15);
        __syncthreads();
        for (int uid = F.vcu; uid < NHEADS * (GROWS / 2); uid += F.G) na_wg_unit(F, uid >> 6, uid & 63);
        __syncthreads();
        if (BOTH(4)) GRID_BAR();
    }
    if (IN(5)) {
        pg8::Gemm g{F.Y, F.WOUT, SEQ, DM, DM}; pg8::StaticOrder S; S.init(SEQ, DM, F.G, (int)blockIdx.x);
        pg8::EpiRes E{F.x, F.out, F.ADAV + 2 * DM};
        pg8::gemm_phase<pg8::EpiRes, pg8::StaticOrder, true, true>(F.lds + RING_OFF, g, S, E);
        if (BOTH(5)) GRID_BAR();
    }
    if (IN(6)) {
        build_tables(F, F.g2, F.ADAV + 4 * DM, F.ADAV + 3 * DM, TA, TB);
        norm_rows<false>(F, F.out, F.H, SEQ, TA, TB);
        __syncthreads();
        if (BOTH(6)) GRID_BAR();
    }
    if (IN(7)) {
        pg8::Gemm g{F.H, F.WUP, SEQ, 2 * DFF, DM}; pg8::StaticOrder S; S.init(SEQ, 2 * DFF, F.G, (int)blockIdx.x);
        pg8::EpiUpConv E{F.ACT, F.HALO, F.conv_w, F.conv_b, DFF, SEQ};
        pg8::gemm_phase<pg8::EpiUpConv, pg8::StaticOrder, true, true>(F.lds + RING_OFF, g, S, E);
        if (BOTH(7)) GRID_BAR();
    }
    if (IN(8)) { conv_fix(F); if (BOTH(8)) GRID_BAR(); }
    if (IN(9)) {
        pg8::Gemm g{F.ACT, F.WDN, SEQ, DM, DFF}; pg8::StaticOrder S; S.init(SEQ, DM, F.G, (int)blockIdx.x);
        pg8::EpiRes E{F.out, F.out, F.ADAV + 5 * DM};
        pg8::gemm_phase<pg8::EpiRes, pg8::StaticOrder, true, true>(F.lds + RING_OFF, g, S, E);
        if (BOTH(9)) GRID_BAR();
    }
    if (IN(10)) {
        build_tables(F, F.g_final, nullptr, nullptr, TA, TB);
        norm_rows<true>(F, F.out, F.out, SEQ, TA, TB);
    }
#undef IN
#undef BOTH
}

extern "C" void kernel_launch(void* const* d_in, const int* in_sizes, int n_in, void* d_out, int out_size, void* d_ws, size_t ws_size, hipStream_t stream) {
    static int grid = 0;
    if (grid == 0) {
        if (n_in != 20 || in_sizes[0] != SEQ * DM || out_size != SEQ * DM || ws_size < WS_END) { fprintf(stderr, "kernel_launch: unexpected shapes (n_in %d, in0 %d, out %d, ws %zu); nothing launched\n", n_in, n_in > 0 ? in_sizes[0] : -1, out_size, ws_size); grid = -1; return; }
        int dev = 0, cus = 0, per_cu = 0;
        if (hipGetDevice(&dev) != hipSuccess || hipDeviceGetAttribute(&cus, hipDeviceAttributeMultiprocessorCount, dev) != hipSuccess) { fprintf(stderr, "kernel_launch: device query failed\n"); grid = -1; return; }
        if (hipFuncSetAttribute((const void*)mk_fwd, hipFuncAttributeMaxDynamicSharedMemorySize, LDS_BYTES) != hipSuccess) { fprintf(stderr, "kernel_launch: hipFuncSetAttribute failed\n"); grid = -1; return; }
        if (hipOccupancyMaxActiveBlocksPerMultiprocessor(&per_cu, (const void*)mk_fwd, NWAVES * 64, LDS_BYTES) != hipSuccess || per_cu < 1)
            fprintf(stderr, "kernel_launch: note: occupancy query reports %d workgroups per CU\n", per_cu);
        (void)hipGetLastError();
        grid = cus;
    }
    if (grid < 0) return;
    if (hipMemsetAsync((char*)d_ws + WS_CTL, 0, CTL_ZERO_BYTES, stream) != hipSuccess) { fprintf(stderr, "kernel_launch: memset failed\n"); return; }
    Args a{};
    for (int i = 0; i < 20; ++i) a.in[i] = (const float*)d_in[i];
    a.out = (float*)d_out; a.ws = (unsigned char*)d_ws;
    for (int li = 0; li < N_LAUNCHES; ++li) {
        a.ph_lo = (N_LAUNCHES == 1) ? 0 : li; a.ph_hi = (N_LAUNCHES == 1) ? N_PHASES : li + 1;
        hipLaunchKernelGGL(mk_fwd, dim3(grid), dim3(NWAVES * 64), LDS_BYTES, stream, a);
        const hipError_t le = hipPeekAtLastError();
        if (le != hipSuccess) { fprintf(stderr, "kernel_launch: launch %d failed: %s\n", li, hipGetErrorName(le)); break; }
    }
}
```

```cpp
#include <hip/hip_runtime.h>
#include <cstdio>
#include <cstdint>

#ifndef MK_N_LAUNCHES
#define MK_N_LAUNCHES 1
#endif

namespace pg8 {
#define PG8_LAS __attribute__((address_space(3)))
typedef unsigned short bf16_t;
typedef short bf16x8 __attribute__((ext_vector_type(8)));
typedef float f32x4 __attribute__((ext_vector_type(4)));
typedef unsigned u32x4 __attribute__((ext_vector_type(4)));
constexpr int BM = 256, BK = 64, HALF = 128, HTB = HALF * BK * 2  , STAGE_BYTES = 8 * HTB, NXCD = 8, WGM = 8;

__host__ __device__ __forceinline__ int lds_byte(int r, int c) { const int st = (r >> 4) * 2 + (c >> 5), rr = r & 15, cc = c & 31, ob = rr * 64 + cc * 2; return st * 1024 + (ob ^ (((ob >> 9) & 1) << 5)); }
__host__ __device__ __forceinline__ void stage_rc(int b, int& R, int& C) { const int st = b / 1024, sb = b % 1024, swz = sb ^ (((sb >> 9) & 1) << 5); R = (st >> 1) * 16 + swz / 64; C = (st & 1) * 32 + (swz % 64) / 2; }
__host__ __device__ __forceinline__ int perm32(int rho) { const int n = rho >> 4, i = rho & 15; return 8 * (i >> 2) + 4 * n + (i & 3); }

struct Unit { int pm, pn; };
struct Gemm { const bf16_t* A; const bf16_t* Bt; int M, N, K, lda, ldb; };

struct StaticOrder {
    int nM, nN, nwg, G, c;
    __host__ __device__ void init(int M, int N, int G_, int c_) { nM = M / BM; nN = N / BM; nwg = nM * nN; G = G_; c = c_; }
    __host__ __device__ bool next(int i, Unit& u) const {
        const long L = (long)i * G + c; if (L >= nwg) return false;
        int wgid = (int)L; { const int q = nwg / NXCD, r = nwg % NXCD, xcd = wgid % NXCD, off = wgid / NXCD; wgid = (xcd < r ? xcd * (q + 1) : r * (q + 1) + (xcd - r) * q) + off; }
        const int nig = WGM * nN, gid = wgid / nig, fm = gid * WGM, gsz = (nM - fm) < WGM ? (nM - fm) : WGM;
        u.pm = fm + ((wgid % nig) % gsz); u.pn = (wgid % nig) / gsz; return true;
    }
    __device__ __forceinline__ void a_ready(const Unit&) const {}
    __device__ __forceinline__ void done(const Unit&) const {}
};

typedef float f32x2_t __attribute__((ext_vector_type(2))); typedef __bf16 bf16x2_t __attribute__((ext_vector_type(2)));
__device__ __forceinline__ unsigned cvtpk(float lo, float hi) { f32x2_t v = {lo, hi}; bf16x2_t b = __builtin_convertvector(v, bf16x2_t); return __builtin_bit_cast(unsigned, b); }
__device__ __forceinline__ float gelu_t(float x) { const float u = x * (1.0f + 0.044715f * x * x); const float e = __builtin_amdgcn_exp2f(-2.302208198f * u); return x * __builtin_amdgcn_rcpf(1.0f + e); }
__device__ __forceinline__ float silu_f(float x) { const float e = __builtin_amdgcn_exp2f(-1.4426950409f * x); return x * __builtin_amdgcn_rcpf(1.0f + e); }

struct EpiIn {
    static constexpr bool PERM = true, AFTER_DRAIN = false;
    bf16_t* base; size_t seg_stride; float* vst;
    __device__ __forceinline__ void operator()(const f32x4 (&acc)[2][2][4][2], const Unit& u, int wr, int wc, int fr, int fq) const {
        const int seg = u.pn >> 3, colt = (u.pn & 7) * BM;
        bf16_t* O = base + (size_t)seg * seg_stride;
        const int row0 = u.pm * BM + wr * 64 + fr, col0 = colt + wc * 32 + 8 * fq;
#pragma unroll
        for (int ai = 0; ai < 2; ++ai)
#pragma unroll
            for (int m = 0; m < 4; ++m) { const int row = row0 + ai * HALF + m * 16; bf16_t* rowp = O + (size_t)row * 2048 + col0; float s = 0.f, s2 = 0.f;
#pragma unroll
                for (int bj = 0; bj < 2; ++bj) { f32x4 v0 = acc[ai][bj][m][0], v1 = acc[ai][bj][m][1];
                    if (seg < 2) {
#pragma unroll
                        for (int j = 0; j < 4; ++j) { v0[j] = gelu_t(v0[j]); v1[j] = gelu_t(v1[j]); }
                    }
                    if (seg == 1) {
#pragma unroll
                        for (int j = 0; j < 4; ++j) { s += v0[j] + v1[j]; s2 += v0[j] * v0[j] + v1[j] * v1[j]; }
                    }
                    u32x4 w; w.x = cvtpk(v0[0], v0[1]); w.y = cvtpk(v0[2], v0[3]); w.z = cvtpk(v1[0], v1[1]); w.w = cvtpk(v1[2], v1[3]);
                    *(u32x4*)(rowp + bj * HALF) = w; }
                if (seg == 1) { s += __shfl_xor(s, 16); s += __shfl_xor(s, 32); s2 += __shfl_xor(s2, 16); s2 += __shfl_xor(s2, 32);
                    if (fq == 0) { f32x2_t pr = {s, s2}; *(f32x2_t*)(vst + ((size_t)row * 32 + (u.pn - 8) * 4 + wc) * 2) = pr; } }
            }
    }
};
struct EpiRes {
    static constexpr bool PERM = false, AFTER_DRAIN = false;
    const float* base; float* out; const float* gate;
    __device__ __forceinline__ void operator()(const f32x4 (&acc)[2][2][4][2], const Unit& u, int wr, int wc, int fr, int fq) const {
        const int row0 = u.pm * BM + wr * 64 + fr, col0 = u.pn * BM + wc * 32 + 4 * fq;
        f32x4 gv[2][2];
#pragma unroll
        for (int bj = 0; bj < 2; ++bj)
#pragma unroll
            for (int n = 0; n < 2; ++n) gv[bj][n] = *(const f32x4*)(gate + col0 + bj * HALF + n * 16);
#pragma unroll
        for (int ai = 0; ai < 2; ++ai)
#pragma unroll
            for (int m = 0; m < 4; ++m) { const size_t off = (size_t)(row0 + ai * HALF + m * 16) * 4096 + col0;
#pragma unroll
                for (int bj = 0; bj < 2; ++bj)
#pragma unroll
                    for (int n = 0; n < 2; ++n) { const f32x4 bs = *(const f32x4*)(base + off + bj * HALF + n * 16); *(f32x4*)(out + off + bj * HALF + n * 16) = bs + gv[bj][n] * acc[ai][bj][m][n]; }
                asm volatile("" ::: "memory"); }
    }
};
template <int CTRL> __device__ __forceinline__ float dppf(float x) { return __builtin_bit_cast(float, __builtin_amdgcn_update_dpp(0, __builtin_bit_cast(int, x), CTRL, 0xf, 0xf, false)); }
struct EpiUpConv {
    static constexpr bool PERM = true, AFTER_DRAIN = false;
    bf16_t* ACT; float* HALO; const float* cw; const float* cb; int ld; int nrows; int ldact;
    __device__ __forceinline__ void operator()(const f32x4 (&acc)[2][2][4][2], const Unit& u, int wr, int wc, int fr, int fq) const {
        const int ch0 = u.pn * HALF + wc * 32 + 8 * fq;
        float w0[8], w1[8], w2[8], bb[8];
#pragma unroll
        for (int h4 = 0; h4 < 2; ++h4) { const f32x4 a = *(const f32x4*)(cw + ch0 + 4 * h4), b = *(const f32x4*)(cw + ld + ch0 + 4 * h4), c = *(const f32x4*)(cw + 2 * ld + ch0 + 4 * h4), d = *(const f32x4*)(cb + ch0 + 4 * h4);
#pragma unroll
            for (int j = 0; j < 4; ++j) { w0[4 * h4 + j] = a[j]; w1[4 * h4 + j] = b[j]; w2[4 * h4 + j] = c[j]; bb[4 * h4 + j] = d[j]; } }
#pragma unroll
        for (int ai = 0; ai < 2; ++ai) { const int Rb = u.pm * BM + ai * HALF + wr * 64;
#pragma unroll
            for (int m = 0; m < 4; ++m) { float t[8], y[8];
#pragma unroll
                for (int c = 0; c < 8; ++c) { const int n = c >> 2, j = c & 3;
                    const float a = acc[ai][0][m][n][j];
                    const float am = m > 0 ? acc[ai][0][m > 0 ? m - 1 : 0][n][j] : 0.f, ap = m < 3 ? acc[ai][0][m < 3 ? m + 1 : 3][n][j] : 0.f;
                    const float prev = dppf<0x121>(fr == 15 ? am : a);
                    const float next = dppf<0x12F>(fr == 0 ? ap : a);
                    t[c] = bb[c] + w0[c] * prev + w1[c] * a + w2[c] * next;
                    y[c] = silu_f(t[c]) * acc[ai][1][m][n][j]; }
                const int row = Rb + 16 * m + fr;
                u32x4 w; w.x = cvtpk(y[0], y[1]); w.y = cvtpk(y[2], y[3]); w.z = cvtpk(y[4], y[5]); w.w = cvtpk(y[6], y[7]);
                *(u32x4*)(ACT + (size_t)row * ldact + ch0) = w;
                if (m == 0 || m == 3) { const bool up = (m == 3);
                    const int R = up ? Rb + 64 : Rb;
                    if (fr == (up ? 15 : 0) && R != 0 && R != nrows) { float* hp = HALO + ((size_t)((R >> 6) * 2 + (up ? 0 : 1)) * 3) * ld + ch0;
#pragma unroll
                        for (int h4 = 0; h4 < 2; ++h4) { const f32x4 pv = {t[4 * h4], t[4 * h4 + 1], t[4 * h4 + 2], t[4 * h4 + 3]};
                            *(f32x4*)(hp + 4 * h4) = pv; *(f32x4*)(hp + ld + 4 * h4) = acc[ai][1][m][h4]; *(f32x4*)(hp + 2 * ld + 4 * h4) = acc[ai][0][m][h4]; } } }
            } }
    }
};

template <class Epi, class Sched, bool ALIGN_EPI = false, bool SP2 = false>
__device__ __forceinline__ void gemm_phase(PG8_LAS unsigned char* lds, const Gemm g, const Sched& S, const Epi& E) {
    const int tid = threadIdx.x, wid = __builtin_amdgcn_readfirstlane(tid >> 6), lane = tid & 63, wr = wid >> 2, wc = wid & 3, fr = lane & 15, fq = lane >> 4;
    const int K = g.K, nt = K / BK;
    unsigned voffA[2], voffB[2];
#pragma unroll
    for (int i = 0; i < 2; ++i) { int R, C; stage_rc(tid * 16 + i * 8192, R, C); const int Rb = Epi::PERM ? ((R & ~31) + perm32(R & 31)) : R;
        voffA[i] = (unsigned)(R * g.lda + C) * 2u; voffB[i] = (unsigned)(Rb * g.ldb + C) * 2u; }
    const size_t kstep = (size_t)(BK * 2);
    const size_t hstepA = (size_t)HALF * g.lda * 2, hstepB = (size_t)HALF * g.ldb * 2;
    const size_t tstepA = 2 * hstepA, tstepB = 2 * hstepB;
    const unsigned ldsw = (unsigned)wid * 1024u;
    const int aoff = lds_byte(wr * 64 + fr, fq * 8), boff = lds_byte(wc * 32 + fr, fq * 8);
#define PG8_SA(b, h) (((b) * 2 + (h)) * HTB)
#define PG8_SB(b, h) ((4 + (b) * 2 + (h)) * HTB)
#define PG8_STAGE(bufoff, gbase, voff) do { _Pragma("unroll") for (int _i = 0; _i < 2; ++_i) \
        __builtin_amdgcn_global_load_lds((const unsigned*)((const char*)(gbase) + (voff)[_i]), (PG8_LAS unsigned*)(lds + (bufoff) + ldsw + _i * 8192), 16, 0, 0); } while (0)
#define PG8_LDA(dst, b, h) do { _Pragma("unroll") for (int m = 0; m < 4; ++m) _Pragma("unroll") for (int k = 0; k < 2; ++k) dst[m][k] = *(const PG8_LAS bf16x8*)(lds + PG8_SA(b, h) + aoff + m * 2048 + k * 1024); } while (0)
#define PG8_LDB(dst, b, h) do { _Pragma("unroll") for (int n = 0; n < 2; ++n) _Pragma("unroll") for (int k = 0; k < 2; ++k) dst[n][k] = *(const PG8_LAS bf16x8*)(lds + PG8_SB(b, h) + boff + n * 2048 + k * 1024); } while (0)
#define PG8_MMA(ai, bj, At, Bt) do { __builtin_amdgcn_s_setprio(1); _Pragma("unroll") for (int m = 0; m < 4; ++m) _Pragma("unroll") for (int n = 0; n < 2; ++n) _Pragma("unroll") for (int k = 0; k < 2; ++k) \
        acc[ai][bj][m][n] = __builtin_amdgcn_mfma_f32_16x16x32_bf16(Bt[n][k], At[m][k], acc[ai][bj][m][n], 0, 0, 0); __builtin_amdgcn_s_setprio(0); } while (0)
#define PG8_WAIT_V(n) asm volatile("s_waitcnt vmcnt(" #n ")" ::: "memory")
#define PG8_WAIT_L(n) asm volatile("s_waitcnt lgkmcnt(" #n ")" ::: "memory")
#define PG8_BAR __builtin_amdgcn_s_barrier()
#define PG8_SCHED __builtin_amdgcn_sched_barrier(0)
    Unit cur, nxt; int ui = 0;
    if (!S.next(0, cur)) return;
    f32x4 acc[2][2][4][2];
#pragma unroll
    for (int a = 0; a < 2; ++a)
#pragma unroll
        for (int b = 0; b < 2; ++b)
#pragma unroll
            for (int m = 0; m < 4; ++m)
#pragma unroll
                for (int n = 0; n < 2; ++n) acc[a][b][m][n] = (f32x4){0.f, 0.f, 0.f, 0.f};
    bf16x8 At[4][2], B0[2][2], B1[2][2];
    const char* cA = (const char*)g.A + (size_t)cur.pm * tstepA; const char* cB = (const char*)g.Bt + (size_t)cur.pn * tstepB;
    S.a_ready(cur);
    if constexpr (SP2) {
        PG8_STAGE(PG8_SB(0, 0), cB, voffB); PG8_STAGE(PG8_SB(0, 1), cB + hstepB, voffB); PG8_STAGE(PG8_SA(0, 0), cA, voffA); PG8_STAGE(PG8_SA(0, 1), cA + hstepA, voffA);
        if (wr == 1) PG8_BAR;
        PG8_WAIT_V(2); PG8_BAR;
        PG8_STAGE(PG8_SB(1, 0), cB + kstep, voffB); PG8_STAGE(PG8_SA(1, 0), cA + kstep, voffA); PG8_STAGE(PG8_SB(1, 1), cB + hstepB + kstep, voffB);
        PG8_WAIT_V(6); PG8_BAR;
    } else {
        PG8_STAGE(PG8_SB(0, 0), cB, voffB); PG8_STAGE(PG8_SA(0, 0), cA, voffA); PG8_STAGE(PG8_SB(0, 1), cB + hstepB, voffB); PG8_STAGE(PG8_SA(0, 1), cA + hstepA, voffA);
        if (wr == 1) PG8_BAR;
        PG8_WAIT_V(4); PG8_BAR;
        PG8_STAGE(PG8_SB(1, 0), cB + kstep, voffB); PG8_STAGE(PG8_SA(1, 0), cA + kstep, voffA); PG8_STAGE(PG8_SB(1, 1), cB + hstepB + kstep, voffB);
        PG8_WAIT_V(6); PG8_BAR;
    }
    for (;;) {
        const bool has_next = S.next(ui + 1, nxt);
        const char* nA = has_next ? (const char*)g.A + (size_t)nxt.pm * tstepA : cA; const char* nB = has_next ? (const char*)g.Bt + (size_t)nxt.pn * tstepB : cB;
        for (int t = 0; t < nt; t += 2) {
            const bool last = (t == nt - 2);
            const char* a1 = cA + (size_t)(t + 1) * kstep;
            const char* a2 = last ? nA : cA + (size_t)(t + 2) * kstep; const char* b2 = last ? nB : cB + (size_t)(t + 2) * kstep;
            const char* a3 = a2 + kstep; const char* b3 = b2 + kstep;
            if (last && has_next) S.a_ready(nxt);
            if constexpr (SP2) {
            PG8_LDB(B0, 0, 0); PG8_LDB(B1, 0, 1); PG8_SCHED; PG8_LDA(At, 0, 0); PG8_STAGE(PG8_SA(1, 1), a1 + hstepA, voffA);
            PG8_WAIT_V(8); PG8_WAIT_L(0); PG8_BAR; PG8_MMA(0, 0, At, B0); PG8_MMA(0, 1, At, B1); PG8_BAR; PG8_SCHED;
            PG8_LDA(At, 0, 1); PG8_STAGE(PG8_SB(0, 0), b2, voffB); PG8_STAGE(PG8_SB(0, 1), b2 + hstepB, voffB); PG8_STAGE(PG8_SA(0, 0), a2, voffA);
            PG8_WAIT_V(8); PG8_WAIT_L(0); PG8_BAR; PG8_MMA(1, 0, At, B0); PG8_MMA(1, 1, At, B1); PG8_BAR; PG8_SCHED;
            PG8_LDB(B0, 1, 0); PG8_LDB(B1, 1, 1); PG8_SCHED; PG8_LDA(At, 1, 0); PG8_STAGE(PG8_SA(0, 1), a2 + hstepA, voffA);
            PG8_WAIT_V(8); PG8_WAIT_L(0); PG8_BAR; PG8_MMA(0, 0, At, B0); PG8_MMA(0, 1, At, B1); PG8_BAR; PG8_SCHED;
            PG8_LDA(At, 1, 1); PG8_STAGE(PG8_SB(1, 0), b3, voffB); PG8_STAGE(PG8_SB(1, 1), b3 + hstepB, voffB); PG8_STAGE(PG8_SA(1, 0), a3, voffA);
            PG8_WAIT_V(8); PG8_WAIT_L(0); PG8_BAR; PG8_MMA(1, 0, At, B0); PG8_MMA(1, 1, At, B1); PG8_BAR; PG8_SCHED;
            } else {
            PG8_LDB(B0, 0, 0); PG8_SCHED; PG8_LDA(At, 0, 0); PG8_STAGE(PG8_SA(1, 1), a1 + hstepA, voffA);
            PG8_WAIT_L(8); PG8_BAR; PG8_WAIT_L(0); PG8_MMA(0, 0, At, B0); PG8_BAR; PG8_SCHED;
            PG8_LDB(B1, 0, 1); PG8_STAGE(PG8_SB(0, 0), b2, voffB);
            PG8_BAR; PG8_WAIT_L(0); PG8_MMA(0, 1, At, B1); PG8_BAR;
            PG8_LDA(At, 0, 1); PG8_STAGE(PG8_SA(0, 0), a2, voffA);
            PG8_BAR; PG8_WAIT_L(0); PG8_MMA(1, 0, At, B0); PG8_BAR; PG8_SCHED;
            PG8_STAGE(PG8_SB(0, 1), b2 + hstepB, voffB);
            PG8_WAIT_V(6); PG8_BAR; PG8_MMA(1, 1, At, B1); PG8_BAR;
            PG8_LDB(B0, 1, 0); PG8_SCHED; PG8_LDA(At, 1, 0); PG8_STAGE(PG8_SA(0, 1), a2 + hstepA, voffA);
            PG8_WAIT_L(8); PG8_BAR; PG8_WAIT_L(0); PG8_MMA(0, 0, At, B0); PG8_BAR; PG8_SCHED;
            PG8_LDB(B1, 1, 1); PG8_STAGE(PG8_SB(1, 0), b3, voffB);
            PG8_BAR; PG8_WAIT_L(0); PG8_MMA(0, 1, At, B1); PG8_BAR;
            PG8_LDA(At, 1, 1); PG8_STAGE(PG8_SA(1, 0), a3, voffA);
            PG8_BAR; PG8_WAIT_L(0); PG8_MMA(1, 0, At, B0); PG8_BAR; PG8_SCHED;
            PG8_STAGE(PG8_SB(1, 1), b3 + hstepB, voffB);
            PG8_WAIT_V(6); PG8_BAR; PG8_MMA(1, 1, At, B1); PG8_BAR;
            }
        }
        if constexpr (ALIGN_EPI) { if (wr == 0) PG8_BAR; }
        if constexpr (!Epi::AFTER_DRAIN) { E(acc, cur, wr, wc, fr, fq); S.done(cur); }
        if (!has_next) break;
#pragma unroll
        for (int a = 0; a < 2; ++a)
#pragma unroll
            for (int b = 0; b < 2; ++b)
#pragma unroll
                for (int m = 0; m < 4; ++m)
#pragma unroll
                    for (int n = 0; n < 2; ++n) acc[a][b][m][n] = (f32x4){0.f, 0.f, 0.f, 0.f};
        cur = nxt; cA = nA; cB = nB; ++ui;
        if constexpr (ALIGN_EPI) { if (wr == 1) PG8_BAR; }
    }
    PG8_WAIT_V(0);
    if constexpr (!ALIGN_EPI) { if (wr == 0) PG8_BAR; }
    PG8_BAR;
    if constexpr (Epi::AFTER_DRAIN) { E.fused(acc, cur, wr, wc, fr, fq, lds, wid, lane); S.done(cur); }
#undef PG8_SA
#undef PG8_SB
#undef PG8_STAGE
#undef PG8_LDA
#undef PG8_LDB
#undef PG8_MMA
#undef PG8_WAIT_V
#undef PG8_WAIT_L
#undef PG8_BAR
#undef PG8_SCHED
}
}

constexpr int NWAVES = 8;
constexpr int N_LAUNCHES = MK_N_LAUNCHES;
constexpr int N_PHASES = 11;
constexpr int DM = 4096, SEQ = 8192, CTXL = 256, GW = 64, GROWS = 128, HD = 128;
constexpr int AW = 2048, NAW = 2048, NHEADS = 16, KH = 8, KW = 16;
constexpr int INC = 10240, KVS = 6144, DFF = 11008, ADA = 6 * DM;
constexpr int MROWS = SEQ + CTXL;
constexpr float EPS = 1e-6f;
constexpr int GEMV_KS = 64;
constexpr size_t MiB = 1u << 20;
constexpr size_t WS_CTL = 0, CTL_ZERO_BYTES = 1 * MiB;
constexpr int LDW = DM + 64, LDH = DM + 64, LDACT = DFF + 64;
constexpr size_t WS_WIN = 2 * MiB;
constexpr size_t WS_WOUT = 84 * MiB;
constexpr size_t WS_WUP = 117 * MiB;
constexpr size_t WS_WDN = 292 * MiB;
constexpr size_t WS_H = 379 * MiB;
constexpr size_t WS_U = 447 * MiB, SEG_BYTES = 32 * MiB;
constexpr size_t WS_KC = 607 * MiB, WS_VC = 608 * MiB;
constexpr size_t WS_Y = 609 * MiB;
constexpr size_t WS_AB = 674 * MiB;
constexpr size_t WS_ACT = 708 * MiB;
constexpr size_t WS_PART = 881 * MiB;
constexpr size_t WS_ADA = 893 * MiB;
constexpr size_t WS_VST = 894 * MiB;
constexpr size_t WS_END = 896 * MiB;
static_assert(WS_WIN + (size_t)INC * LDW * 2 <= WS_WOUT && WS_WOUT + (size_t)DM * LDW * 2 <= WS_WUP && WS_WUP + (size_t)2 * DFF * LDW * 2 <= WS_WDN && WS_WDN + (size_t)DM * LDACT * 2 <= WS_H, "ws map 1");
static_assert(WS_H + (size_t)MROWS * LDH * 2 <= WS_U && WS_U + 5 * SEG_BYTES <= WS_KC && WS_Y + (size_t)SEQ * LDH * 2 <= WS_AB && WS_AB + (size_t)128 * 2 * 3 * DFF * 4 <= WS_ACT && WS_ACT + (size_t)SEQ * LDACT * 2 <= WS_PART, "ws map 2");
constexpr int CW_BAR = 4096;
constexpr int RING_OFF = 0, RING_BYTES = 131072;
constexpr int LDSCTL_OFF = RING_BYTES, MISC_OFF = LDSCTL_OFF + 320;
constexpr int LDS_BYTES = 147456;
static_assert(MISC_OFF + 128 <= LDS_BYTES, "LDS map");

#define GAS __attribute__((address_space(1)))
#define LAS __attribute__((address_space(3)))
typedef unsigned short bf16;
typedef unsigned v4u __attribute__((ext_vector_type(4)));
typedef unsigned v2u __attribute__((ext_vector_type(2)));
typedef float f32x4 __attribute__((ext_vector_type(4)));
typedef float f32x2 __attribute__((ext_vector_type(2)));
typedef short bf16x8 __attribute__((ext_vector_type(8)));
typedef short s16x4 __attribute__((ext_vector_type(4)));
typedef short v4i16_t __attribute__((ext_vector_type(4)));
typedef GAS unsigned gu32;
#define RLX_AGENT __ATOMIC_RELAXED, __HIP_MEMORY_SCOPE_AGENT
#define LDS_WAIT() asm volatile("s_waitcnt lgkmcnt(0)" ::: "memory")
#define VM_WAIT() asm volatile("s_waitcnt vmcnt(0)" ::: "memory")
using pg8::cvtpk; using pg8::gelu_t; using pg8::silu_f;
__device__ __forceinline__ float bf_lo(unsigned w) { return __uint_as_float(w << 16); }
__device__ __forceinline__ float bf_hi(unsigned w) { return __uint_as_float(w & 0xffff0000u); }
__device__ __forceinline__ s16x4 vtr(const LAS unsigned char* p) { return __builtin_bit_cast(s16x4, __builtin_amdgcn_ds_read_tr16_b64_v4i16((LAS v4i16_t*)p)); }
__device__ __forceinline__ float wave_sum(float v) {
#pragma unroll
    for (int o = 1; o < 64; o <<= 1) v += __shfl_xor(v, o);
    return v;
}
#define XB_TMO      128
#define XB_XCNT(j)  (256  + 64 * (j))
#define XB_XSUB(j)  (1280 + 64 * (j))
#define XB_XGEN(j)  (2304 + 64 * (j))
#define XB_TOP      3328
#define XB_TOPGEN   3392
#define XCD_BAR_WORDS 3456
#define XB_SPIN_CAP (1u << 18)

__device__ __forceinline__ unsigned xb_ld(unsigned* p)              { return __hip_atomic_load(p, __ATOMIC_RELAXED, __HIP_MEMORY_SCOPE_AGENT); }
__device__ __forceinline__ unsigned xb_add(unsigned* p, unsigned v) { return __hip_atomic_fetch_add(p, v, __ATOMIC_RELAXED, __HIP_MEMORY_SCOPE_AGENT); }
__device__ __forceinline__ unsigned xb_xcc_id() { return (unsigned)__builtin_amdgcn_s_getreg((3 << 11) | 20) & 0xFu; }
#define XB_SPIN(cond, bar) do { unsigned _sp = 0; while (cond) { __builtin_amdgcn_s_sleep(1); \
    if ((++_sp & 255u) == 0u) { if (xb_ld(&(bar)[XB_TMO])) break; if (_sp > XB_SPIN_CAP) { atomicAdd(&(bar)[XB_TMO], 1u); break; } } } } while (0)

struct XcdBarrier {
    unsigned* bar; unsigned x;
    volatile LAS unsigned* st;
};

__device__ __forceinline__ XcdBarrier xcd_barrier_post(unsigned* bar, volatile LAS unsigned* st) {
    XcdBarrier b; b.bar = bar; b.x = xb_xcc_id(); b.st = st;
    if (threadIdx.x == 0) (void)xb_add(&bar[XB_XCNT(b.x)], 1u);
    return b;
}
__device__ __forceinline__ void xcd_barrier_complete(unsigned* bar, unsigned x, unsigned& nloc, unsigned& nx) {
    const unsigned G = gridDim.x * gridDim.y * gridDim.z;
    unsigned sum, cnt, mine, sp = 0u;
    for (;;) {
        sum = 0u; cnt = 0u; mine = 0u;
#pragma unroll
        for (unsigned j = 0; j < 16; ++j) { const unsigned c = xb_ld(&bar[XB_XCNT(j)]); sum += c; cnt += (c > 0u) ? 1u : 0u; mine = (j == x) ? c : mine; }
        if (sum == G) break;
        __builtin_amdgcn_s_sleep(1);
        if ((++sp & 255u) == 0u) { if (xb_ld(&bar[XB_TMO])) break; if (sp > XB_SPIN_CAP) { atomicAdd(&bar[XB_TMO], 1u); break; } }
    }
    nloc = mine > 0u ? mine : 1u; nx = cnt > 0u ? cnt : 1u;
}

__device__ __forceinline__ void xcd_barrier(const XcdBarrier& b) {
    asm volatile("s_waitcnt vmcnt(0)" ::: "memory");
    __syncthreads();
    if (threadIdx.x == 0) {
        unsigned* bar = b.bar;
        __builtin_amdgcn_s_waitcnt(0);
        unsigned nloc = b.st[0], nx = b.st[1];
        if (nloc == 0u) { xcd_barrier_complete(bar, b.x, nloc, nx); b.st[0] = nloc; b.st[1] = nx; }
        const unsigned old = xb_add(&bar[XB_XSUB(b.x)], 1u);
        const unsigned gen = old / nloc;
        if (old + 1u == (gen + 1u) * nloc) {
            __builtin_amdgcn_fence(__ATOMIC_RELEASE, "agent");
            asm volatile("s_waitcnt vmcnt(0)" ::: "memory");
            const unsigned og = xb_add(&bar[XB_TOP], 1u);
            const unsigned tg = og / nx;
            if (og + 1u == (tg + 1u) * nx) xb_add(&bar[XB_TOPGEN], 1u);
            else XB_SPIN(xb_ld(&bar[XB_TOPGEN]) == tg, bar);
            __builtin_amdgcn_fence(__ATOMIC_ACQUIRE, "agent");
            xb_add(&bar[XB_XGEN(b.x)], 1u);
            asm volatile("s_waitcnt vmcnt(0)" ::: "memory");
        } else {
            XB_SPIN(xb_ld(&bar[XB_XGEN(b.x)]) == gen, bar);
            __builtin_amdgcn_fence(__ATOMIC_ACQUIRE, "agent");
            asm volatile("s_waitcnt vmcnt(0)" ::: "memory");
        }
    }
    __syncthreads();
}

struct Frame {
    LAS unsigned char* lds;
    volatile LAS unsigned* MISC;
    gu32* ctl;
    int tid, lane, wave;
    int vcu, G;
    const float *x, *cvec, *ctx, *cctx, *w_ada, *b_ada, *g1, *w_in, *ln_g, *ln_b, *w_s, *b_s, *rpb, *w_out, *g2, *w_up, *conv_w, *conv_b, *w_down, *g_final;
    float* out;
    bf16 *WIN, *WOUT, *WUP, *WDN, *H, *U, *V, *Q, *K, *VA, *KC, *VC, *Y, *AB, *GB, *ACT;
    float *PART, *ADAV, *VST, *HALO;
};

__device__ __forceinline__ void tr_item(const float* W, int ldw, int N, bf16* WT, int k0, int n0, int drow0, LAS float* scr, int lane) {
#pragma unroll 8
    for (int i = 0; i < 32; ++i) { const int kk = 2 * i + (lane >> 5); scr[kk * 33 + (lane & 31)] = W[(size_t)(k0 + kk) * N + n0 + (lane & 31)]; }
    LDS_WAIT(); asm volatile("" ::: "memory");
    const int c = lane & 7;
#pragma unroll
    for (int j = 0; j < 4; ++j) { const int n = (lane >> 3) + 8 * j; const LAS float* s = scr + (8 * c) * 33 + n;
        v4u o; o.x = cvtpk(s[0 * 33], s[1 * 33]); o.y = cvtpk(s[2 * 33], s[3 * 33]); o.z = cvtpk(s[4 * 33], s[5 * 33]); o.w = cvtpk(s[6 * 33], s[7 * 33]);
        *(GAS v4u*)(WT + (size_t)(drow0 + n) * ldw + k0 + 8 * c) = o; }
    LDS_WAIT(); asm volatile("" ::: "memory");
}
__device__ __forceinline__ void gemv_item(Frame& F, int item) {
    const int cc = item % 96, ks = item / 96, k0 = ks * 64;
    const float s0v = silu_f(F.cvec[k0 + F.lane]), s1v = silu_f(F.cctx[k0 + F.lane]);
    const GAS float* W = (const GAS float*)F.w_ada + (size_t)k0 * ADA + cc * 256 + 4 * F.lane;
    f32x4 a0 = {0.f, 0.f, 0.f, 0.f}, a1 = {0.f, 0.f, 0.f, 0.f};
#pragma unroll 8
    for (int kk = 0; kk < 64; ++kk) {
        const f32x4 w = *(const GAS f32x4*)(W + (size_t)kk * ADA);
        const float s0 = __uint_as_float(__builtin_amdgcn_readlane(__float_as_uint(s0v), kk));
        const float s1 = __uint_as_float(__builtin_amdgcn_readlane(__float_as_uint(s1v), kk));
        a0 += w * s0; a1 += w * s1;
    }
    GAS float* P = (GAS float*)F.PART + ((size_t)ks * 2) * ADA + cc * 256 + 4 * F.lane;
    *(GAS f32x4*)P = a0; *(GAS f32x4*)(P + ADA) = a1;
}
__device__ __forceinline__ void p0_phase(Frame& F) {
    LAS float* scr = (LAS float*)(F.lds + RING_OFF + F.wave * 16384);
    const int gw = F.vcu * NWAVES + F.wave, NGW = F.G * NWAVES;
    for (int it = gw; it < 96 * GEMV_KS; it += NGW) gemv_item(F, it);
    constexpr int NB_IN = INC / 32, I_IN = (DM / 64) * NB_IN;
    for (int it = gw; it < I_IN; it += NGW) { const int kb = it / NB_IN, nb = it % NB_IN; tr_item(F.w_in, LDW, INC, F.WIN, 64 * kb, 32 * nb, 32 * nb, scr, F.lane); }
}
__device__ __forceinline__ void p1_phase(Frame& F) {
    LAS float* scr = (LAS float*)(F.lds + RING_OFF + F.wave * 16384);
    const int gw = F.vcu * NWAVES + F.wave, NGW = F.G * NWAVES;
    for (int i = F.vcu * 512 + F.tid; i < 2 * ADA; i += F.G * 512) { const int v = i / ADA, n = i - v * ADA; float s = F.b_ada[n];
#pragma unroll 8
        for (int ks = 0; ks < GEMV_KS; ++ks) s += F.PART[((size_t)ks * 2 + v) * ADA + n];
        F.ADAV[i] = s; }
    constexpr int NB_O = DM / 32, I_O = (DM / 64) * NB_O;
    constexpr int NB_U = (2 * DFF) / 32, I_U = (DM / 64) * NB_U;
    constexpr int NB_D = DM / 32, I_D = (DFF / 64) * NB_D;
    for (int it = gw; it < I_O + I_U + I_D; it += NGW) {
        int r = it;
        if (r < I_O) { const int kb = r / NB_O, nb = r % NB_O; tr_item(F.w_out, LDW, DM, F.WOUT, 64 * kb, 32 * nb, 32 * nb, scr, F.lane); continue; } r -= I_O;
        if (r < I_U) { const int kb = r / NB_U, nb = r % NB_U; const int n0 = 32 * nb; const int isg = n0 >= DFF ? 1 : 0; const int f = n0 - isg * DFF;
                       tr_item(F.w_up, LDW, 2 * DFF, F.WUP, 64 * kb, n0, 256 * (f >> 7) + 128 * isg + (f & 127), scr, F.lane); continue; } r -= I_U;
        { const int kb = r / NB_D, nb = r % NB_D; tr_item(F.w_down, LDACT, DM, F.WDN, 64 * kb, 32 * nb, 32 * nb, scr, F.lane); }
    }
}
template <bool F32OUT>
__device__ __forceinline__ void norm_rows(Frame& F, const float* src, void* dst, int ldd, int nrows, const LAS float* TA, const LAS float* TB) {
    const int gw = F.vcu * NWAVES + F.wave, NGW = F.G * NWAVES;
    for (int row = gw; row < nrows; row += NGW) {
        const GAS f32x4* xr = (const GAS f32x4*)(src + (size_t)row * DM) + F.lane;
        f32x4 v[16]; float ss = 0.f;
#pragma unroll
        for (int j = 0; j < 16; ++j) { v[j] = xr[64 * j]; ss += (v[j].x * v[j].x + v[j].y * v[j].y) + (v[j].z * v[j].z + v[j].w * v[j].w); }
        ss = wave_sum(ss);
        const float rstd = 1.0f / sqrtf(ss * (1.0f / DM) + EPS);
        if (F32OUT) { GAS f32x4* o = (GAS f32x4*)((float*)dst + (size_t)row * ldd) + F.lane;
#pragma unroll
            for (int j = 0; j < 16; ++j) { const f32x4 a = *(const LAS f32x4*)(TA + 4 * (F.lane + 64 * j)); o[64 * j] = v[j] * rstd * a; } }
        else { GAS v2u* o = (GAS v2u*)((bf16*)dst + (size_t)row * ldd) + F.lane;
#pragma unroll
            for (int j = 0; j < 16; ++j) { const f32x4 a = *(const LAS f32x4*)(TA + 4 * (F.lane + 64 * j)), b = *(const LAS f32x4*)(TB + 4 * (F.lane + 64 * j));
                const f32x4 y = v[j] * rstd * a + b; v2u w; w.x = cvtpk(y.x, y.y); w.y = cvtpk(y.z, y.w); o[64 * j] = w; } }
    }
}
__device__ __forceinline__ void build_tables(Frame& F, const float* g, const float* scale, const float* shift, LAS float* TA, LAS float* TB) {
    for (int i = F.tid; i < DM; i += NWAVES * 64) { TA[i] = scale ? g[i] * (1.0f + scale[i]) : g[i]; TB[i] = shift ? shift[i] : 0.f; }
    LDS_WAIT(); __syncthreads();
}
__device__ __forceinline__ void ctx_kv(Frame& F) {
    for (int b = F.vcu; b < 256; b += F.G) {
        const int tm = b >> 6, tn = b & 63, wm = F.wave >> 2, wn = F.wave & 3, g = F.lane >> 4, qi = F.lane & 15;
        const GAS bf16* Ap = (const GAS bf16*)F.H + (size_t)(SEQ + 64 * tm + 32 * wm + qi) * LDH + 8 * g;
        const GAS bf16* Bp = (const GAS bf16*)F.WIN + (size_t)(KVS + 64 * tn + 16 * wn + qi) * LDW + 8 * g;
        f32x4 acc0 = {0.f, 0.f, 0.f, 0.f}, acc1 = {0.f, 0.f, 0.f, 0.f};
#pragma unroll 4
        for (int k = 0; k < DM; k += 32) {
            const bf16x8 a0 = *(const GAS bf16x8*)(Ap + k), a1 = *(const GAS bf16x8*)(Ap + (size_t)16 * LDH + k), bb = *(const GAS bf16x8*)(Bp + k);
            acc0 = __builtin_amdgcn_mfma_f32_16x16x32_bf16(a0, bb, acc0, 0, 0, 0);
            acc1 = __builtin_amdgcn_mfma_f32_16x16x32_bf16(a1, bb, acc1, 0, 0, 0);
        }
        const int col = 64 * tn + 16 * wn + qi;
        GAS bf16* dst = (GAS bf16*)(col < NAW ? F.KC : F.VC) + (col & (NAW - 1));
        const int rbase = 64 * tm + 32 * wm + 4 * g;
#pragma unroll
        for (int j = 0; j < 4; ++j) { dst[(size_t)(rbase + j) * NAW] = (bf16)(cvtpk(acc0[j], 0.f) & 0xffffu); dst[(size_t)(rbase + 16 + j) * NAW] = (bf16)(cvtpk(acc1[j], 0.f) & 0xffffu); }
    }
}
constexpr int GM_STAT = 0, GM_WS = 1024, GM_WS_STRIDE = 272, GM_VLN = GM_WS + 128 * GM_WS_STRIDE, GM_VLN_STRIDE = 288, GM_END = GM_VLN + 128 * GM_VLN_STRIDE;
static_assert(GM_END <= RING_BYTES, "gMLP LDS");
__device__ __forceinline__ void gmlp_unit(Frame& F, int c, int gch) {
    LAS unsigned char* L = F.lds + RING_OFF;
    LAS f32x2* STAT = (LAS f32x2*)(L + GM_STAT);
    const int tid = F.tid, lane = F.lane, g = lane >> 4, qi = lane & 15;
    f32x4 st4[4];
    { const GAS f32x4* p = (const GAS f32x4*)((const GAS float*)F.VST + ((size_t)(128 * c + (tid >> 2)) * 32 + (tid & 3) * 8) * 2);
#pragma unroll
      for (int i = 0; i < 4; ++i) st4[i] = p[i]; }
    f32x4 wreg[8];
#pragma unroll
    for (int i = 0; i < 8; ++i) { const int idx = tid + 512 * i, p = idx >> 5, q4 = idx & 31; wreg[i] = *(const GAS f32x4*)(F.w_s + ((size_t)gch * 128 + p) * 128 + 4 * q4); }
    const int ch8 = tid & 15, cb = gch * 128 + 8 * ch8;
    v4u vraw[4];
#pragma unroll
    for (int i = 0; i < 4; ++i) vraw[i] = *(const GAS v4u*)(F.V + (size_t)(128 * c + (tid >> 4) + 32 * i) * AW + cb);
    const f32x4 lg0 = *(const GAS f32x4*)(F.ln_g + cb), lg1 = *(const GAS f32x4*)(F.ln_g + cb + 4), lb0 = *(const GAS f32x4*)(F.ln_b + cb), lb1 = *(const GAS f32x4*)(F.ln_b + cb + 4);
    v2u gu[8]; float bs[8];
    const int ocol = 128 * gch + 16 * F.wave + 4 * g;
#pragma unroll
    for (int nf = 0; nf < 8; ++nf) { const int p = 16 * nf + qi; gu[nf] = *(const GAS v2u*)(F.U + (size_t)(128 * c + p) * AW + ocol); bs[nf] = F.b_s[gch * 128 + p]; }
    { float s = 0.f, s2 = 0.f;
#pragma unroll
      for (int i = 0; i < 4; ++i) { s += st4[i].x + st4[i].z; s2 += st4[i].y + st4[i].w; }
      s += __shfl_xor(s, 1); s2 += __shfl_xor(s2, 1); s += __shfl_xor(s, 2); s2 += __shfl_xor(s2, 2);
      if ((tid & 3) == 0) { const float mean = s * (1.0f / AW), var = s2 * (1.0f / AW) - mean * mean; f32x2 st = {mean, 1.0f / sqrtf(var + EPS)}; STAT[tid >> 2] = st; } }
#pragma unroll
    for (int i = 0; i < 8; ++i) { const int idx = tid + 512 * i, p = idx >> 5, q4 = idx & 31;
        v2u o; o.x = cvtpk(wreg[i].x, wreg[i].y); o.y = cvtpk(wreg[i].z, wreg[i].w); *(LAS v2u*)(L + GM_WS + p * GM_WS_STRIDE + 8 * q4) = o; }
    LDS_WAIT(); __syncthreads();
#pragma unroll
    for (int i = 0; i < 4; ++i) { const int q = (tid >> 4) + 32 * i; const v4u raw = vraw[i];
        const f32x2 st = STAT[q]; const float mu = st.x, rs = st.y;
        v4u o;
        o.x = cvtpk((bf_lo(raw.x) - mu) * rs * lg0.x + lb0.x, (bf_hi(raw.x) - mu) * rs * lg0.y + lb0.y);
        o.y = cvtpk((bf_lo(raw.y) - mu) * rs * lg0.z + lb0.z, (bf_hi(raw.y) - mu) * rs * lg0.w + lb0.w);
        o.z = cvtpk((bf_lo(raw.z) - mu) * rs * lg1.x + lb1.x, (bf_hi(raw.z) - mu) * rs * lg1.y + lb1.y);
        o.w = cvtpk((bf_lo(raw.w) - mu) * rs * lg1.z + lb1.z, (bf_hi(raw.w) - mu) * rs * lg1.w + lb1.w);
        *(LAS v4u*)(L + GM_VLN + q * GM_VLN_STRIDE + 16 * ch8) = o; }
    LDS_WAIT(); __syncthreads();
    f32x4 acc[8];
#pragma unroll
    for (int nf = 0; nf < 8; ++nf) acc[nf] = (f32x4){0.f, 0.f, 0.f, 0.f};
    const LAS unsigned char* va = L + GM_VLN + (4 * g + (qi >> 2)) * GM_VLN_STRIDE + 32 * F.wave + 8 * (qi & 3);
    const LAS unsigned char* wa = L + GM_WS + qi * GM_WS_STRIDE + 8 * g;
#pragma unroll
    for (int kb = 0; kb < 4; ++kb) {
        const s16x4 lo = vtr(va + kb * 32 * GM_VLN_STRIDE), hi = vtr(va + (kb * 32 + 16) * GM_VLN_STRIDE);
        const bf16x8 af = (bf16x8){lo[0], lo[1], lo[2], lo[3], hi[0], hi[1], hi[2], hi[3]};
#pragma unroll
        for (int nf = 0; nf < 8; ++nf) {
            const s16x4 b0 = *(const LAS s16x4*)(wa + nf * 16 * GM_WS_STRIDE + kb * 64), b1 = *(const LAS s16x4*)(wa + nf * 16 * GM_WS_STRIDE + kb * 64 + 32);
            const bf16x8 bfr = (bf16x8){b0[0], b0[1], b0[2], b0[3], b1[0], b1[1], b1[2], b1[3]};
            acc[nf] = __builtin_amdgcn_mfma_f32_16x16x32_bf16(af, bfr, acc[nf], 0, 0, 0);
        }
    }
#pragma unroll
    for (int nf = 0; nf < 8; ++nf) { const int p = 16 * nf + qi; const size_t row = (size_t)(128 * c + p);
        v2u o; o.x = cvtpk(bf_lo(gu[nf].x) * (acc[nf][0] + bs[nf]), bf_hi(gu[nf].x) * (acc[nf][1] + bs[nf])); o.y = cvtpk(bf_lo(gu[nf].y) * (acc[nf][2] + bs[nf]), bf_hi(gu[nf].y) * (acc[nf][3] + bs[nf]));
        *(GAS v2u*)(F.Y + row * LDH + ocol) = o; }
    LDS_WAIT(); __syncthreads();
}
constexpr int NAK_STRIDE = 272, NAV_STRIDE = 288, NA_KBUF = 64 * NAK_STRIDE, NA_VBUF = 64 * NAV_STRIDE, NA_BUF = NA_KBUF + NA_VBUF, NA_BIAS = 2 * NA_BUF;
static_assert(NA_BIAS + 15 * 128 <= RING_BYTES, "NA LDS");
__device__ __forceinline__ void na_wg_unit(Frame& F, int h, int rp) {
    LAS unsigned char* L = F.lds + RING_OFF;
    const int tid = F.tid, lane = F.lane, g = lane >> 4, qi = lane & 15;
    const int ri = F.wave >> 2, jb = F.wave & 3, r = 2 * rp + ri;
    const int r0 = min(max(r - KH / 2, 0), GROWS - KH);
    const int kr_lo = min(max(2 * rp - KH / 2, 0), GROWS - KH), kr_hi = min(max(2 * rp + 1 - KH / 2, 0), GROWS - KH) + KH - 1;
    const int nsteps = 4 + (kr_hi - kr_lo + 1);
    const int qc = 16 * jb + qi, tq = GW * r + qc;
    const int c0 = min(max(qc - KW / 2, 0), GW - KW);
    const float L2E = 1.4426950408889634f, CS = 0.08838834764831845f * L2E;
    const GAS bf16* Qp = (const GAS bf16*)F.Q + (size_t)tq * NAW + h * HD + 8 * g;
    bf16x8 qf[4];
#pragma unroll
    for (int s = 0; s < 4; ++s) qf[s] = *(const GAS bf16x8*)(Qp + 32 * s);
    for (int i = tid; i < 15 * 32; i += NWAVES * 64) { const int dr = i >> 5, dc = i & 31; ((LAS float*)(L + NA_BIAS))[i] = dc < 31 ? F.rpb[(h * (2 * KH - 1) + dr) * (2 * KW - 1) + dc] * L2E : -INFINITY; }
    int bidx[16];
#pragma unroll
    for (int e = 0; e < 16; ++e) { const int kc = 16 * (e >> 2) + 4 * g + (e & 3); const bool valid = (kc >= c0) && (kc < c0 + KW); bidx[e] = 4 * (valid ? kc - qc + (KW - 1) : 31); }
    f32x4 o[8];
#pragma unroll
    for (int nf = 0; nf < 8; ++nf) o[nf] = (f32x4){0.f, 0.f, 0.f, 0.f};
    float m = -1e30f, l = 0.f;
    const int lrow = tid >> 4, lch = tid & 15;
    const size_t lofs = (size_t)lrow * NAW + h * HD + 8 * lch;
    const int kw_off = lrow * NAK_STRIDE + 16 * lch, vw_off = NA_KBUF + lrow * NAV_STRIDE + 16 * lch;
    v4u kreg[2], vreg[2];
    { const GAS bf16* Kb = (const GAS bf16*)F.KC + lofs; const GAS bf16* Vb = (const GAS bf16*)F.VC + lofs;
#pragma unroll
      for (int i = 0; i < 2; ++i) { kreg[i] = *(const GAS v4u*)(Kb + (size_t)32 * i * NAW); vreg[i] = *(const GAS v4u*)(Vb + (size_t)32 * i * NAW); }
#pragma unroll
      for (int i = 0; i < 2; ++i) { *(LAS v4u*)(L + kw_off + 32 * i * NAK_STRIDE) = kreg[i]; *(LAS v4u*)(L + vw_off + 32 * i * NAV_STRIDE) = vreg[i]; }
      LDS_WAIT(); __syncthreads(); }
    const int ka_off = qi * NAK_STRIDE + 16 * g;
    const int tr_off = NA_KBUF + (4 * g + (qi >> 2)) * NAV_STRIDE + 8 * (qi & 3);
#pragma unroll 1
    for (int st = 0; st < nsteps; ++st) {
        const bool more = st + 1 < nsteps;
        if (more) { const int s1 = st + 1; const GAS bf16 *Kb, *Vb;
            if (s1 < 4) { Kb = (const GAS bf16*)F.KC + (size_t)(64 * s1) * NAW + lofs; Vb = (const GAS bf16*)F.VC + (size_t)(64 * s1) * NAW + lofs; }
            else { const size_t tok0 = (size_t)GW * (kr_lo + s1 - 4); Kb = (const GAS bf16*)F.K + tok0 * NAW + lofs; Vb = (const GAS bf16*)F.VA + tok0 * NAW + lofs; }
#pragma unroll
            for (int i = 0; i < 2; ++i) { kreg[i] = *(const GAS v4u*)(Kb + (size_t)32 * i * NAW); vreg[i] = *(const GAS v4u*)(Vb + (size_t)32 * i * NAW); } }
        const LAS unsigned char* B = L + (st & 1) * NA_BUF;
        const bool local = st >= 4; const int kr = kr_lo + st - 4;
        const bool active = !local || (kr >= r0 && kr < r0 + KH);
        if (active) {
            const bool act0 = !local || jb != 3, act1 = !local || jb != 0;
            const LAS unsigned char* brow = L + NA_BIAS + (local ? (kr - r + (KH - 1)) * 128 : 0);
            float xs[16];
#pragma unroll
            for (int half = 0; half < 2; ++half) {
                if (half == 0 ? act0 : act1) {
                    const LAS unsigned char* Kt = B + ka_off + 32 * half * NAK_STRIDE;
                    f32x4 s0 = {0.f, 0.f, 0.f, 0.f}, s1 = {0.f, 0.f, 0.f, 0.f};
#pragma unroll
                    for (int s = 0; s < 4; ++s) {
                        const bf16x8 k0 = *(const LAS bf16x8*)(Kt + 64 * s), k1 = *(const LAS bf16x8*)(Kt + 16 * NAK_STRIDE + 64 * s);
                        s0 = __builtin_amdgcn_mfma_f32_16x16x32_bf16(k0, qf[s], s0, 0, 0, 0);
                        s1 = __builtin_amdgcn_mfma_f32_16x16x32_bf16(k1, qf[s], s1, 0, 0, 0);
                    }
                    if (local) {
#pragma unroll
                        for (int e = 0; e < 4; ++e) { xs[8 * half + e] = s0[e] * CS + *(const LAS float*)(brow + bidx[8 * half + e]); xs[8 * half + 4 + e] = s1[e] * CS + *(const LAS float*)(brow + bidx[8 * half + 4 + e]); }
                    } else {
#pragma unroll
                        for (int e = 0; e < 4; ++e) { xs[8 * half + e] = s0[e] * CS; xs[8 * half + 4 + e] = s1[e] * CS; }
                    }
                } else {
#pragma unroll
                    for (int e = 0; e < 8; ++e) xs[8 * half + e] = -INFINITY;
                }
            }
            float mx = fmaxf(fmaxf(fmaxf(xs[0], xs[1]), fmaxf(xs[2], xs[3])), fmaxf(fmaxf(xs[4], xs[5]), fmaxf(xs[6], xs[7])));
            mx = fmaxf(mx, fmaxf(fmaxf(fmaxf(xs[8], xs[9]), fmaxf(xs[10], xs[11])), fmaxf(fmaxf(xs[12], xs[13]), fmaxf(xs[14], xs[15]))));
            mx = fmaxf(mx, __shfl_xor(mx, 16)); mx = fmaxf(mx, __shfl_xor(mx, 32));
            if (__any(mx > m)) {
                const float mn = fmaxf(m, mx), alpha = __builtin_amdgcn_exp2f(m - mn);
                l *= alpha; m = mn;
#pragma unroll
                for (int nf = 0; nf < 8; ++nf) o[nf] = o[nf] * alpha;
            }
            float ps = 0.f; float p[16];
#pragma unroll
            for (int e = 0; e < 16; ++e) { p[e] = __builtin_amdgcn_exp2f(xs[e] - m); ps += p[e]; }
            l += ps;
#pragma unroll
            for (int half = 0; half < 2; ++half) {
                if (half == 0 ? act0 : act1) {
                    const v4u pw = {cvtpk(p[8 * half + 0], p[8 * half + 1]), cvtpk(p[8 * half + 2], p[8 * half + 3]), cvtpk(p[8 * half + 4], p[8 * half + 5]), cvtpk(p[8 * half + 6], p[8 * half + 7])};
                    const bf16x8 pf = __builtin_bit_cast(bf16x8, pw);
                    const LAS unsigned char* Vt = B + tr_off + 32 * half * NAV_STRIDE;
#pragma unroll
                    for (int nf = 0; nf < 8; ++nf) {
                        const s16x4 lo = vtr(Vt + 32 * nf), hi = vtr(Vt + 16 * NAV_STRIDE + 32 * nf);
                        const bf16x8 vf = (bf16x8){lo[0], lo[1], lo[2], lo[3], hi[0], hi[1], hi[2], hi[3]};
                        o[nf] = __builtin_amdgcn_mfma_f32_16x16x32_bf16(vf, pf, o[nf], 0, 0, 0);
                    }
                }
            }
        }
        if (more) { LAS unsigned char* W = L + ((st + 1) & 1) * NA_BUF;
#pragma unroll
            for (int i = 0; i < 2; ++i) { *(LAS v4u*)(W + kw_off + 32 * i * NAK_STRIDE) = kreg[i]; *(LAS v4u*)(W + vw_off + 32 * i * NAV_STRIDE) = vreg[i]; } }
        LDS_WAIT(); __syncthreads();
    }
    l += __shfl_xor(l, 16); l += __shfl_xor(l, 32);
    const float inv = 1.0f / l;
    GAS bf16* Op = (GAS bf16*)F.Y + (size_t)tq * LDH + AW + h * HD + 4 * g;
#pragma unroll
    for (int nf = 0; nf < 8; ++nf) { v2u w; w.x = cvtpk(o[nf][0] * inv, o[nf][1] * inv); w.y = cvtpk(o[nf][2] * inv, o[nf][3] * inv); *(GAS v2u*)(Op + 16 * nf) = w; }
}
__device__ __forceinline__ void conv_fix(Frame& F) {
    constexpr int NCG = DFF / 4, TOTAL = (SEQ / 64 - 1) * 2 * NCG;
    for (int it = F.vcu * 512 + F.tid; it < TOTAL; it += F.G * 512) {
        const int cg = it % NCG, rem = it / NCG, side = rem & 1, bd = 1 + (rem >> 1), f = 4 * cg;
        const GAS float* H0 = (const GAS float*)F.HALO + ((size_t)(bd * 2 + 0) * 3) * DFF + f; const GAS float* H1 = (const GAS float*)F.HALO + ((size_t)(bd * 2 + 1) * 3) * DFF + f;
        const GAS float* Hm = side ? H1 : H0; const GAS float* Ho = side ? H0 : H1;
        const f32x4 P = *(const GAS f32x4*)Hm, gg = *(const GAS f32x4*)(Hm + DFF), ao = *(const GAS f32x4*)(Ho + 2 * DFF);
        const f32x4 w = *(const GAS f32x4*)((const GAS float*)F.conv_w + (side ? 0 : 2 * DFF) + f);
        const f32x4 t = P + w * ao;
        const int row = 64 * bd - 1 + side;
        v2u o; o.x = cvtpk(silu_f(t.x) * gg.x, silu_f(t.y) * gg.y); o.y = cvtpk(silu_f(t.z) * gg.z, silu_f(t.w) * gg.w);
        *(GAS v2u*)((GAS bf16*)F.ACT + (size_t)row * LDACT + f) = o;
    }
}

struct Args { const float* in[20]; float* out; unsigned char* ws; int ph_lo, ph_hi; };
__global__ void __launch_bounds__(NWAVES * 64, 2) mk_fwd(Args args) {
    extern __shared__ __attribute__((aligned(16))) unsigned char lds[];
    Frame F;
    F.lds = (LAS unsigned char*)lds;
    F.MISC = (volatile LAS unsigned*)(F.lds + MISC_OFF);
    F.tid = threadIdx.x; F.lane = F.tid & 63; F.wave = __builtin_amdgcn_readfirstlane(F.tid >> 6);
    F.G = gridDim.x; { const int bx = blockIdx.x; F.vcu = (F.G % 8 == 0) ? (bx % 8) * (F.G / 8) + bx / 8 : bx; }
    unsigned char* ws = args.ws;
    F.ctl = (gu32*)(ws + WS_CTL);
    F.x = args.in[0]; F.cvec = args.in[1]; F.ctx = args.in[2]; F.cctx = args.in[3]; F.w_ada = args.in[4]; F.b_ada = args.in[5]; F.g1 = args.in[6]; F.w_in = args.in[7];
    F.ln_g = args.in[8]; F.ln_b = args.in[9]; F.w_s = args.in[10]; F.b_s = args.in[11]; F.rpb = args.in[12]; F.w_out = args.in[13]; F.g2 = args.in[14]; F.w_up = args.in[15];
    F.conv_w = args.in[16]; F.conv_b = args.in[17]; F.w_down = args.in[18]; F.g_final = args.in[19]; F.out = args.out;
    F.WIN = (bf16*)(ws + WS_WIN); F.WOUT = (bf16*)(ws + WS_WOUT); F.WUP = (bf16*)(ws + WS_WUP); F.WDN = (bf16*)(ws + WS_WDN); F.H = (bf16*)(ws + WS_H);
    F.U = (bf16*)(ws + WS_U); F.V = (bf16*)(ws + WS_U + SEG_BYTES); F.Q = (bf16*)(ws + WS_U + 2 * SEG_BYTES); F.K = (bf16*)(ws + WS_U + 3 * SEG_BYTES); F.VA = (bf16*)(ws + WS_U + 4 * SEG_BYTES);
    F.KC = (bf16*)(ws + WS_KC); F.VC = (bf16*)(ws + WS_VC); F.Y = (bf16*)(ws + WS_Y); F.ACT = (bf16*)(ws + WS_ACT);
    F.PART = (float*)(ws + WS_PART); F.ADAV = (float*)(ws + WS_ADA); F.VST = (float*)(ws + WS_VST); F.HALO = (float*)(ws + WS_AB);
    for (int u = F.tid; u < (LDS_BYTES - LDSCTL_OFF) / 4; u += NWAVES * 64) ((LAS unsigned*)(F.lds + LDSCTL_OFF))[u] = 0u;
    __syncthreads();
    XcdBarrier bar; bar.bar = (unsigned*)(F.ctl + CW_BAR); bar.x = 0; bar.st = nullptr;
    if (N_LAUNCHES == 1) bar = xcd_barrier_post((unsigned*)(F.ctl + CW_BAR), F.MISC + 8);
#define GRID_BAR() do { if (N_LAUNCHES == 1) xcd_barrier(bar); } while (0)
    const int lo = args.ph_lo, hi = args.ph_hi;
#define IN(k) (lo <= (k) && (k) < hi)
#define BOTH(k) (IN(k) && IN((k) + 1))
    LAS float* TA = (LAS float*)(F.lds + RING_OFF); LAS float* TB = TA + DM;

    if (IN(0)) { p0_phase(F); if (BOTH(0)) GRID_BAR(); }
    if (IN(1)) { p1_phase(F); if (BOTH(1)) GRID_BAR(); }
    if (IN(2)) {
        build_tables(F, F.g1, F.ADAV + DM, F.ADAV, TA, TB);
        norm_rows<false>(F, F.x, F.H, LDH, SEQ, TA, TB);
        __syncthreads();
        build_tables(F, F.g1, F.ADAV + ADA + DM, F.ADAV + ADA, TA, TB);
        norm_rows<false>(F, F.ctx, F.H + (size_t)SEQ * LDH, LDH, CTXL, TA, TB);
        __syncthreads();
        if (BOTH(2)) GRID_BAR();
    }
    if (IN(3)) {
        ctx_kv(F);
        VM_WAIT(); __syncthreads();
        pg8::Gemm g{F.H, F.WIN, SEQ, INC, DM, LDH, LDW}; pg8::StaticOrder S; S.init(SEQ, INC, F.G, (int)blockIdx.x);
        pg8::EpiIn E{F.U, (size_t)SEG_BYTES / 2, F.VST};
        pg8::gemm_phase<pg8::EpiIn, pg8::StaticOrder, true, true>(F.lds + RING_OFF, g, S, E);
        if (BOTH(3)) GRID_BAR();
    }
    if (IN(4)) {
        for (int uid = F.vcu; uid < 1024; uid += F.G) gmlp_unit(F, uid >> 4, uid & 15);
        __syncthreads();
        for (int uid = F.vcu; uid < NHEADS * (GROWS / 2); uid += F.G) na_wg_unit(F, uid >> 6, uid & 63);
        __syncthreads();
        if (BOTH(4)) GRID_BAR();
    }
    if (IN(5)) {
        pg8::Gemm g{F.Y, F.WOUT, SEQ, DM, DM, LDH, LDW}; pg8::StaticOrder S; S.init(SEQ, DM, F.G, (int)blockIdx.x);
        pg8::EpiRes E{F.x, F.out, F.ADAV + 2 * DM};
        pg8::gemm_phase<pg8::EpiRes, pg8::StaticOrder, true, true>(F.lds + RING_OFF, g, S, E);
        if (BOTH(5)) GRID_BAR();
    }
    if (IN(6)) {
        build_tables(F, F.g2, F.ADAV + 4 * DM, F.ADAV + 3 * DM, TA, TB);
        norm_rows<false>(F, F.out, F.H, LDH, SEQ, TA, TB);
        __syncthreads();
        if (BOTH(6)) GRID_BAR();
    }
    if (IN(7)) {
        pg8::Gemm g{F.H, F.WUP, SEQ, 2 * DFF, DM, LDH, LDW}; pg8::StaticOrder S; S.init(SEQ, 2 * DFF, F.G, (int)blockIdx.x);
        pg8::EpiUpConv E{F.ACT, F.HALO, F.conv_w, F.conv_b, DFF, SEQ, LDACT};
        pg8::gemm_phase<pg8::EpiUpConv, pg8::StaticOrder, true, true>(F.lds + RING_OFF, g, S, E);
        if (BOTH(7)) GRID_BAR();
    }
    if (IN(8)) { conv_fix(F); if (BOTH(8)) GRID_BAR(); }
    if (IN(9)) {
        pg8::Gemm g{F.ACT, F.WDN, SEQ, DM, DFF, LDACT, LDACT}; pg8::StaticOrder S; S.init(SEQ, DM, F.G, (int)blockIdx.x);
        pg8::EpiRes E{F.out, F.out, F.ADAV + 5 * DM};
        pg8::gemm_phase<pg8::EpiRes, pg8::StaticOrder, true, true>(F.lds + RING_OFF, g, S, E);
        if (BOTH(9)) GRID_BAR();
    }
    if (IN(10)) {
        build_tables(F, F.g_final, nullptr, nullptr, TA, TB);
        norm_rows<true>(F, F.out, F.out, DM, SEQ, TA, TB);
    }
#undef IN
#undef BOTH
}

extern "C" void kernel_launch(void* const* d_in, const int* in_sizes, int n_in, void* d_out, int out_size, void* d_ws, size_t ws_size, hipStream_t stream) {
    static int grid = 0;
    if (grid == 0) {
        if (n_in != 20 || in_sizes[0] != SEQ * DM || out_size != SEQ * DM || ws_size < WS_END) { fprintf(stderr, "kernel_launch: unexpected shapes (n_in %d, in0 %d, out %d, ws %zu); nothing launched\n", n_in, n_in > 0 ? in_sizes[0] : -1, out_size, ws_size); grid = -1; return; }
        int dev = 0, cus = 0, per_cu = 0;
        if (hipGetDevice(&dev) != hipSuccess || hipDeviceGetAttribute(&cus, hipDeviceAttributeMultiprocessorCount, dev) != hipSuccess) { fprintf(stderr, "kernel_launch: device query failed\n"); grid = -1; return; }
        if (hipFuncSetAttribute((const void*)mk_fwd, hipFuncAttributeMaxDynamicSharedMemorySize, LDS_BYTES) != hipSuccess) { fprintf(stderr, "kernel_launch: hipFuncSetAttribute failed\n"); grid = -1; return; }
        if (hipOccupancyMaxActiveBlocksPerMultiprocessor(&per_cu, (const void*)mk_fwd, NWAVES * 64, LDS_BYTES) != hipSuccess || per_cu < 1)
            fprintf(stderr, "kernel_launch: note: occupancy query reports %d workgroups per CU\n", per_cu);
        (void)hipGetLastError();
        grid = cus;
    }
    if (grid < 0) return;
    if (hipMemsetAsync((char*)d_ws + WS_CTL, 0, CTL_ZERO_BYTES, stream) != hipSuccess) { fprintf(stderr, "kernel_launch: memset failed\n"); return; }
    Args a{};
    for (int i = 0; i < 20; ++i) a.in[i] = (const float*)d_in[i];
    a.out = (float*)d_out; a.ws = (unsigned char*)d_ws;
    for (int li = 0; li < N_LAUNCHES; ++li) {
        a.ph_lo = (N_LAUNCHES == 1) ? 0 : li; a.ph_hi = (N_LAUNCHES == 1) ? N_PHASES : li + 1;
        hipLaunchKernelGGL(mk_fwd, dim3(grid), dim3(NWAVES * 64), LDS_BYTES, stream, a);
        const hipError_t le = hipPeekAtLastError();
        if (le != hipSuccess) { fprintf(stderr, "kernel_launch: launch %d failed: %s\n", li, hipGetErrorName(le)); break; }
    }
}
```
